# Optimizing an MI355X kernel written in HIP

```python
import jax, jax.numpy as jnp
from jax import lax
import numpy as np

D_MODEL = 2048
BATCH = 4
SEQ = 4096
DEPTH = 1

CHUNK = 64
Q_BLOCK = 128
MIX_WIDTH = D_MODEL

RWKV_HEAD_DIM = 64
RWKV_WIDTH = MIX_WIDTH // 2
RWKV_HEADS = RWKV_WIDTH // RWKV_HEAD_DIM
DECAY_LORA = 96
ICLR_LORA = 96
GATE_LORA = 256
GN_EPS = 64e-5

QK_NOPE_DIM = 128
QK_ROPE_DIM = 64
V_HEAD_DIM = 128
MLA_WIDTH = MIX_WIDTH - RWKV_WIDTH
MLA_HEADS = MLA_WIDTH // V_HEAD_DIM
Q_LORA_RANK = 512
KV_LORA_RANK = 256
ROPE_THETA = 10000.0

D_FF = 5632
CONV_WIDTH = 3

NORM_EPS = 1e-6
N_MOD = 6

RWKV_COLS = 3 * RWKV_WIDTH + DECAY_LORA + ICLR_LORA + GATE_LORA
MLA_COLS = Q_LORA_RANK + KV_LORA_RANK + QK_ROPE_DIM
IN_COLS = RWKV_COLS + MLA_COLS

kernel_name = "hybrid_rwkv7_mla_convffn_block"


def rms_norm(x, g):
    xf = x.astype(jnp.float32)
    y = xf * lax.rsqrt(jnp.mean(xf * xf, axis=-1, keepdims=True) + NORM_EPS)
    return (y * g.astype(jnp.float32)).astype(x.dtype)


def shift_prev(u):
    return jnp.pad(u, ((0, 0), (1, 0), (0, 0)))[:, :-1]


def apply_rope(u, cos, sin):
    u1, u2 = jnp.split(u, 2, axis=-1)
    return jnp.concatenate([u1 * cos - u2 * sin, u1 * sin + u2 * cos], axis=-1)


def rwkv7_mixer(p, mu_shift, w0, w_decay_up, a0, w_iclr_up, w_gate_up, k_k, k_a, r_k, ln_x_g, ln_x_b):
    B, S, _ = p.shape
    H, N, W = RWKV_HEADS, RWKV_HEAD_DIM, RWKV_WIDTH
    f32 = jnp.float32
    p = p + (shift_prev(p) - p) * mu_shift
    r, k, v, wd, ad, gd = jnp.split(
        p, [W, 2 * W, 3 * W, 3 * W + DECAY_LORA, 3 * W + DECAY_LORA + ICLR_LORA], axis=-1)
    w_log = -jax.nn.softplus(-(w0 + jnp.tanh(wd) @ w_decay_up)) - 0.5
    decay = jnp.exp(-jnp.exp(w_log.astype(f32)))
    a = jax.nn.sigmoid(a0 + ad @ w_iclr_up)
    g = jax.nn.sigmoid(gd) @ w_gate_up
    kk = (k * k_k).reshape(B, S, H, N).astype(f32)
    kk = kk / jnp.maximum(jnp.sqrt(jnp.sum(kk * kk, axis=-1, keepdims=True)), 1e-12)
    k = k * (1.0 + (a - 1.0) * k_a)

    def heads(t):
        return t.reshape(B, S, H, N).astype(f32)

    r_h, k_h, v_h, w_h, a_h = heads(r), heads(k), heads(v), heads(decay), heads(a)

    def step(state, inp):
        r_t, w_t, k_t, v_t, kk_t, a_t = inp
        sa = jnp.einsum('bhvk,bhk->bhv', state, -kk_t)
        state = (state * w_t[:, :, None, :]
                 + sa[..., None] * (kk_t * a_t)[:, :, None, :]
                 + v_t[..., None] * k_t[:, :, None, :])
        y_t = jnp.einsum('bhvk,bhk->bhv', state, r_t)
        return state, y_t

    xs = tuple(jnp.moveaxis(t, 1, 0) for t in (r_h, w_h, k_h, v_h, kk, a_h))
    _, y = lax.scan(step, jnp.zeros((B, H, N, N), f32), xs)
    y = jnp.moveaxis(y, 0, 1)
    mean = jnp.mean(y, axis=-1, keepdims=True)
    var = jnp.mean(jnp.square(y - mean), axis=-1, keepdims=True)
    y = ((y - mean) * lax.rsqrt(var + GN_EPS)).reshape(B, S, W) * ln_x_g + ln_x_b
    bonus = jnp.sum(r_h * k_h * r_k, axis=-1, keepdims=True) * v_h
    y = (y + bonus.reshape(B, S, W)) * g
    return y.astype(p.dtype)


def mla_mixer(p, positions, q_norm_g, w_q_up, kv_norm_g, w_kv_up):
    B, S, _ = p.shape
    H, DN, DR, DV = MLA_HEADS, QK_NOPE_DIM, QK_ROPE_DIM, V_HEAD_DIM
    f32 = jnp.float32
    q_lat, kv_lat, k_rope = jnp.split(p, [Q_LORA_RANK, Q_LORA_RANK + KV_LORA_RANK], axis=-1)
    q = (rms_norm(q_lat, q_norm_g) @ w_q_up).reshape(B, S, H, DN + DR)
    q_nope, q_rope = q[..., :DN], q[..., DN:]
    kv = (rms_norm(kv_lat, kv_norm_g) @ w_kv_up).reshape(B, S, H, DN + DV)
    k_nope, v = kv[..., :DN], kv[..., DN:]
    inv_freq = ROPE_THETA ** (-jnp.arange(0, DR, 2, dtype=f32) / DR)
    ang = positions.astype(f32)[..., None] * inv_freq
    cos, sin = jnp.cos(ang), jnp.sin(ang)
    q_rope = apply_rope(q_rope.astype(f32), cos[:, :, None], sin[:, :, None]).astype(q.dtype)
    k_rope = apply_rope(k_rope.astype(f32), cos, sin).astype(q.dtype)
    scale = (DN + DR) ** -0.5
    n_blk = S // Q_BLOCK
    k_chunk = jnp.arange(S) // CHUNK

    def q_block(args):
        i, qn, qr = args
        s = (jnp.einsum('bqhd,bkhd->bhqk', qn, k_nope)
             + jnp.einsum('bqhr,bkr->bhqk', qr, k_rope)).astype(f32) * scale
        q_chunk = (i * Q_BLOCK + jnp.arange(Q_BLOCK)) // CHUNK
        mask = q_chunk[:, None] >= k_chunk[None, :]
        s = jnp.where(mask[None, None], s, -jnp.inf)
        prob = jax.nn.softmax(s, axis=-1).astype(v.dtype)
        return jnp.einsum('bhqk,bkhd->bqhd', prob, v)

    qn_b = q_nope.reshape(B, n_blk, Q_BLOCK, H, DN).transpose(1, 0, 2, 3, 4)
    qr_b = q_rope.reshape(B, n_blk, Q_BLOCK, H, DR).transpose(1, 0, 2, 3, 4)
    o = lax.map(q_block, (jnp.arange(n_blk), qn_b, qr_b))
    return o.transpose(1, 0, 2, 3, 4).reshape(B, S, H * DV)


def conv_ffn(h, w_ffn_up, conv_w, conv_b, w_ffn_down):
    S = h.shape[1]
    u = h @ w_ffn_up
    up = jnp.pad(u, ((0, 0), (CONV_WIDTH - 1, 0), (0, 0)))
    uc = conv_b + conv_w[CONV_WIDTH - 1] * u
    for j in range(CONV_WIDTH - 1):
        uc = uc + conv_w[j] * up[:, j:j + S]
    gate, val = jnp.split(uc, 2, axis=-1)
    return (jax.nn.gelu(gate, approximate=True) * val) @ w_ffn_down


def setup_inputs(seed: int = 0) -> dict:
    key = jax.random.key(seed)
    ks = iter(jax.random.split(key, 40))
    L, D = DEPTH, D_MODEL
    f32 = jnp.float32

    def nrm(shape, scale):
        return jax.random.normal(next(ks), shape, f32) * scale

    def gain(shape):
        return 1.0 + nrm(shape, 0.02)

    x = nrm((BATCH, SEQ, D), 1.0)
    c = nrm((BATCH, D), 1.0)
    start = jax.random.randint(next(ks), (BATCH, 1), 0, 8192, dtype=jnp.int32)
    positions = (start + jnp.arange(SEQ, dtype=jnp.int32)[None, :]).astype(jnp.int32)
    return {
        "x": x,
        "c": c,
        "positions": positions,
        "w_mod": nrm((L, D, N_MOD * D), D ** -0.5),
        "b_mod": nrm((L, N_MOD * D), 0.01),
        "g_pre_mix": gain((L, D)),
        "w_in": nrm((L, D, IN_COLS), D ** -0.5),
        "mu_shift": jax.random.uniform(next(ks), (L, RWKV_COLS), f32),
        "w0": jax.random.uniform(next(ks), (L, RWKV_WIDTH), f32, -6.0, 1.0),
        "w_decay_up": nrm((L, DECAY_LORA, RWKV_WIDTH), 0.1 * DECAY_LORA ** -0.5),
        "a0": nrm((L, RWKV_WIDTH), 0.1),
        "w_iclr_up": nrm((L, ICLR_LORA, RWKV_WIDTH), 0.5 * ICLR_LORA ** -0.5),
        "w_gate_up": nrm((L, GATE_LORA, RWKV_WIDTH), GATE_LORA ** -0.5),
        "k_k": 0.85 + nrm((L, RWKV_WIDTH), 0.02),
        "k_a": gain((L, RWKV_WIDTH)),
        "r_k": nrm((L, RWKV_HEADS, RWKV_HEAD_DIM), 0.1),
        "ln_x_g": gain((L, RWKV_WIDTH)),
        "ln_x_b": nrm((L, RWKV_WIDTH), 0.01),
        "q_norm_g": gain((L, Q_LORA_RANK)),
        "w_q_up": nrm((L, Q_LORA_RANK, MLA_HEADS * (QK_NOPE_DIM + QK_ROPE_DIM)), Q_LORA_RANK ** -0.5),
        "kv_norm_g": gain((L, KV_LORA_RANK)),
        "w_kv_up": nrm((L, KV_LORA_RANK, MLA_HEADS * (QK_NOPE_DIM + V_HEAD_DIM)), KV_LORA_RANK ** -0.5),
        "w_out": nrm((L, MIX_WIDTH, D), MIX_WIDTH ** -0.5),
        "g_post_mix": gain((L, D)),
        "g_pre_ffn": gain((L, D)),
        "w_ffn_up": nrm((L, D, 2 * D_FF), D ** -0.5),
        "conv_w": nrm((L, CONV_WIDTH, 2 * D_FF), CONV_WIDTH ** -0.5),
        "conv_b": nrm((L, 2 * D_FF), 0.01),
        "w_ffn_down": nrm((L, D_FF, D), D_FF ** -0.5),
        "g_post_ffn": gain((L, D)),
    }


def reference(x, c, positions, w_mod, b_mod, g_pre_mix, w_in, mu_shift, w0, w_decay_up, a0,
              w_iclr_up, w_gate_up, k_k, k_a, r_k, ln_x_g, ln_x_b, q_norm_g, w_q_up, kv_norm_g,
              w_kv_up, w_out, g_post_mix, g_pre_ffn, w_ffn_up, conv_w, conv_b, w_ffn_down, g_post_ffn):
    silu_c = jax.nn.silu(c)
    for l in range(DEPTH):
        mod = (silu_c @ w_mod[l] + b_mod[l])[:, None, :]
        shift_m, scale_m, gate_m, shift_f, scale_f, gate_f = jnp.split(mod, N_MOD, axis=-1)

        h = rms_norm(x, g_pre_mix[l]) * (1.0 + scale_m) + shift_m
        p = h @ w_in[l]
        y_rwkv = rwkv7_mixer(p[..., :RWKV_COLS], mu_shift[l], w0[l], w_decay_up[l], a0[l],
                             w_iclr_up[l], w_gate_up[l], k_k[l], k_a[l], r_k[l],
                             ln_x_g[l], ln_x_b[l])
        y_mla = mla_mixer(p[..., RWKV_COLS:], positions, q_norm_g[l], w_q_up[l],
                          kv_norm_g[l], w_kv_up[l])
        o = jnp.concatenate([y_rwkv, y_mla], axis=-1) @ w_out[l]
        x = x + gate_m * rms_norm(o, g_post_mix[l])

        h = rms_norm(x, g_pre_ffn[l]) * (1.0 + scale_f) + shift_f
        o = conv_ffn(h, w_ffn_up[l], conv_w[l], conv_b[l], w_ffn_down[l])
        x = x + gate_f * rms_norm(o, g_post_ffn[l])
    return x
```

```cpp
#include <hip/hip_runtime.h>
#include <cstdio>
#include <cstdint>

#ifndef MK_CHECK
#define MK_CHECK 0
#endif
#ifndef MK_ONE_LAUNCH
#define MK_ONE_LAUNCH 1
#endif

constexpr int DM = 2048, NB = 4, SEQ = 4096, TOK = NB * SEQ;
constexpr int RW = 1024, RH = 16, RN = 64;
constexpr int IN_COLS = 4352;
constexpr int C_R = 0, C_K = 1024, C_V = 2048, C_WD = 3072, C_AD = 3168, C_GD = 3264, C_QL = 3520, C_KVL = 4032, C_KR = 4288;
constexpr int QLR = 512, KVLR = 256, MH = 8, DN = 128, DR = 64, DV = 128, QHD = 192;
constexpr int QW = MH * QHD, KVW = MH * (DN + DV);
constexpr int DFF = 5632, UPW = 2 * DFF;
constexpr float NORM_EPS = 1e-6f, GN_EPS = 64e-5f;
constexpr int LAW = 512;

constexpr size_t MiB = 1u << 20;
constexpr size_t WS_CTL = 0, CTL_ZERO_BYTES = 64 * 1024;
constexpr size_t WS_MODP = 1 * MiB;
constexpr size_t WS_RSTDQ = 1 * MiB + 800 * 1024;
constexpr size_t WS_RSTDKV = WS_RSTDQ + 64 * 1024;
constexpr size_t WS_SSQ1 = 2 * MiB, WS_SSQ2 = 4 * MiB;
constexpr size_t WS_HEAD = 6 * MiB, WS_TAIL = 12 * MiB;
constexpr size_t WS_WIN = 18 * MiB, WS_WQ = 35 * MiB, WS_WKV = 37 * MiB, WS_WOUT = 38 * MiB, WS_WUP = 46 * MiB, WS_WDOWN = 90 * MiB;
constexpr size_t WS_WDEC = 112 * MiB, WS_WICLR = WS_WDEC + 256 * 1024, WS_WGATE = WS_WICLR + 256 * 1024;
constexpr size_t WS_CONV = WS_WGATE + 512 * 1024;
constexpr size_t WS_H = 114 * MiB;
constexpr size_t WS_LA = WS_H;
constexpr size_t WS_P = 178 * MiB;
constexpr size_t WS_Q = 314 * MiB;
constexpr size_t WS_KV = 362 * MiB;
constexpr size_t WS_KR = 426 * MiB;
constexpr size_t WS_CS = 428 * MiB;
constexpr size_t WS_YCAT = 432 * MiB;
constexpr size_t WS_END = 496 * MiB;
constexpr size_t WS_O1 = WS_Q;
constexpr size_t WS_ACT = WS_P;
constexpr size_t WS_O2 = WS_YCAT;
static_assert(WS_ACT + (size_t)TOK * DFF * 2 <= WS_KV + 64 * MiB, "act overlay");

#define GAS __attribute__((address_space(1)))
#define LAS __attribute__((address_space(3)))
typedef unsigned short bf16_t;
typedef short bf16x8 __attribute__((ext_vector_type(8)));
typedef float f32x4 __attribute__((ext_vector_type(4)));
typedef float f32x2 __attribute__((ext_vector_type(2)));
typedef float f32x16 __attribute__((ext_vector_type(16)));
typedef unsigned u32x4 __attribute__((ext_vector_type(4)));
typedef unsigned u32x2 __attribute__((ext_vector_type(2)));
typedef short s16x4 __attribute__((ext_vector_type(4)));
typedef GAS unsigned gu32;

__device__ __forceinline__ unsigned cvt_pk_bf16(float lo, float hi) { unsigned r; asm volatile("v_cvt_pk_bf16_f32 %0, %1, %2" : "=v"(r) : "v"(lo), "v"(hi)); return r; }
__device__ __forceinline__ float bf2f(unsigned short u) { return __uint_as_float((unsigned)u << 16); }
__device__ __forceinline__ float bflo(unsigned w) { return __uint_as_float(w << 16); }
__device__ __forceinline__ float bfhi(unsigned w) { return __uint_as_float(w & 0xffff0000u); }
__device__ __forceinline__ unsigned short f2bf(float f) { return (unsigned short)(cvt_pk_bf16(f, f) & 0xffffu); }
__device__ __forceinline__ float wave_sum(float v) {
#pragma unroll
    for (int o = 1; o < 64; o <<= 1) v += __shfl_xor(v, o);
    return v;
}
__device__ __forceinline__ float fast_exp(float x) { return __builtin_amdgcn_exp2f(x * 1.4426950408889634f); }
__device__ __forceinline__ float fast_sigmoid(float x) { return __builtin_amdgcn_rcpf(1.f + fast_exp(-x)); }
__device__ __forceinline__ float fast_tanh(float x) { return 1.f - 2.f * __builtin_amdgcn_rcpf(1.f + fast_exp(2.f * x)); }
namespace pg8 {
constexpr int BM = 256, BK = 64, HALF = 128, HTB = HALF * BK * 2, STAGE_BYTES = 8 * HTB, NXCD = 8, WGM = 8;
__host__ __device__ __forceinline__ int lds_byte(int r, int c) { const int st = (r >> 4) * 2 + (c >> 5), rr = r & 15, cc = c & 31, ob = rr * 64 + cc * 2; return st * 1024 + (ob ^ (((ob >> 9) & 1) << 5)); }
__host__ __device__ __forceinline__ void stage_rc(int b, int& R, int& C) { const int st = b / 1024, sb = b % 1024, swz = sb ^ (((sb >> 9) & 1) << 5); R = (st >> 1) * 16 + swz / 64; C = (st & 1) * 32 + (swz % 64) / 2; }
__host__ __device__ __forceinline__ int perm32(int rho) { const int n = rho >> 4, i = rho & 15; return 8 * (i >> 2) + 4 * n + (i & 3); }

struct Unit { int pm, pn; };
struct Gemm { const bf16_t* A; const bf16_t* Bt; int M, N, K, lda, ldb; };

struct StaticOrder {
    int nM, nN, nwg, G, c, flip = 0;
    __host__ __device__ void init(int M, int N, int G_, int c_) { nM = M / BM; nN = N / BM; nwg = nM * nN; G = G_; c = c_; }
    __host__ __device__ bool next(int i, Unit& u) const {
        const long L = (long)i * G + c; if (L >= nwg) return false;
        int wgid = (int)L; { const int q = nwg / NXCD, r = nwg % NXCD, xcd = wgid % NXCD, off = wgid / NXCD; wgid = (xcd < r ? xcd * (q + 1) : r * (q + 1) + (xcd - r) * q) + off; }
        const int nig = WGM * nN, gid = wgid / nig, fm = gid * WGM, gsz = (nM - fm) < WGM ? (nM - fm) : WGM;
        u.pm = fm + ((wgid % nig) % gsz); u.pn = (wgid % nig) / gsz; if (flip) u.pn = nN - 1 - u.pn; return true;
    }
};


template <class Epi, class Sched>
__device__ __forceinline__ void gemm_phase(LAS unsigned char* lds, const Gemm g, const Sched& S, const Epi& E) {
    const int tid = threadIdx.x, wid = __builtin_amdgcn_readfirstlane(tid >> 6), lane = tid & 63, wr = wid >> 2, wc = wid & 3, fr = lane & 15, fq = lane >> 4;
    const int K = g.K, nt = K / BK;
    unsigned voffA[2], voffB[2];
#pragma unroll
    for (int i = 0; i < 2; ++i) { int R, C; stage_rc(tid * 16 + i * 8192, R, C); const int Rb = (R & ~31) + perm32(R & 31);
        voffA[i] = (unsigned)(R * g.lda + C) * 2u; voffB[i] = (unsigned)(Rb * g.ldb + C) * 2u; }
    const size_t kstep = (size_t)(BK * 2);
    const size_t hstepA = (size_t)HALF * g.lda * 2, hstepB = (size_t)HALF * g.ldb * 2;
    const size_t tstepA = 2 * hstepA, tstepB = 2 * hstepB;
    const unsigned ldsw = (unsigned)wid * 1024u;
    const int aoff = lds_byte(wr * 64 + fr, fq * 8), boff = lds_byte(wc * 32 + fr, fq * 8);
#define PG8_SA(b, h) (((b) * 2 + (h)) * HTB)
#define PG8_SB(b, h) ((4 + (b) * 2 + (h)) * HTB)
#define PG8_STAGE(bufoff, gbase, voff) do { _Pragma("unroll") for (int _i = 0; _i < 2; ++_i) \
        __builtin_amdgcn_global_load_lds((const unsigned*)((const char*)(gbase) + (voff)[_i]), (LAS unsigned*)(lds + (bufoff) + ldsw + _i * 8192), 16, 0, 0); } while (0)
#define PG8_LDA(dst, b, h) do { _Pragma("unroll") for (int m = 0; m < 4; ++m) _Pragma("unroll") for (int k = 0; k < 2; ++k) dst[m][k] = *(const LAS bf16x8*)(lds + PG8_SA(b, h) + aoff + m * 2048 + k * 1024); } while (0)
#define PG8_LDB(dst, b, h) do { _Pragma("unroll") for (int n = 0; n < 2; ++n) _Pragma("unroll") for (int k = 0; k < 2; ++k) dst[n][k] = *(const LAS bf16x8*)(lds + PG8_SB(b, h) + boff + n * 2048 + k * 1024); } while (0)
#define PG8_MMA(ai, bj, At, Bt) do { __builtin_amdgcn_s_setprio(1); _Pragma("unroll") for (int m = 0; m < 4; ++m) _Pragma("unroll") for (int n = 0; n < 2; ++n) _Pragma("unroll") for (int k = 0; k < 2; ++k) \
        acc[ai][bj][m][n] = __builtin_amdgcn_mfma_f32_16x16x32_bf16(Bt[n][k], At[m][k], acc[ai][bj][m][n], 0, 0, 0); __builtin_amdgcn_s_setprio(0); } while (0)
#define PG8_WAIT_V(n) asm volatile("s_waitcnt vmcnt(" #n ")" ::: "memory")
#define PG8_WAIT_L(n) asm volatile("s_waitcnt lgkmcnt(" #n ")" ::: "memory")
#define PG8_BAR __builtin_amdgcn_s_barrier()
#define PG8_SCHED __builtin_amdgcn_sched_barrier(0)
    Unit cur, nxt; int ui = 0;
    if (!S.next(0, cur)) return;
    f32x4 acc[2][2][4][2];
#pragma unroll
    for (int a = 0; a < 2; ++a)
#pragma unroll
        for (int b = 0; b < 2; ++b)
#pragma unroll
            for (int m = 0; m < 4; ++m)
#pragma unroll
                for (int n = 0; n < 2; ++n) acc[a][b][m][n] = (f32x4){0.f, 0.f, 0.f, 0.f};
    bf16x8 At[4][2], B0[2][2], B1[2][2];
    const char* cA = (const char*)g.A + (size_t)cur.pm * tstepA; const char* cB = (const char*)g.Bt + (size_t)cur.pn * tstepB;
    PG8_STAGE(PG8_SB(0, 0), cB, voffB); PG8_STAGE(PG8_SB(0, 1), cB + hstepB, voffB); PG8_STAGE(PG8_SA(0, 0), cA, voffA); PG8_STAGE(PG8_SA(0, 1), cA + hstepA, voffA);
    if (wr == 1) PG8_BAR;
    PG8_WAIT_V(2); PG8_BAR;
    PG8_STAGE(PG8_SB(1, 0), cB + kstep, voffB); PG8_STAGE(PG8_SA(1, 0), cA + kstep, voffA); PG8_STAGE(PG8_SB(1, 1), cB + hstepB + kstep, voffB);
    PG8_WAIT_V(6); PG8_BAR;
    for (;;) {
        const bool has_next = S.next(ui + 1, nxt);
        const char* nA = has_next ? (const char*)g.A + (size_t)nxt.pm * tstepA : cA; const char* nB = has_next ? (const char*)g.Bt + (size_t)nxt.pn * tstepB : cB;
        for (int t = 0; t < nt; t += 2) {
            const bool last = (t == nt - 2);
            const char* a1 = cA + (size_t)(t + 1) * kstep;
            const char* a2 = last ? nA : cA + (size_t)(t + 2) * kstep; const char* b2 = last ? nB : cB + (size_t)(t + 2) * kstep;
            const char* a3 = a2 + kstep; const char* b3 = b2 + kstep;
            PG8_LDB(B0, 0, 0); PG8_LDB(B1, 0, 1); PG8_SCHED; PG8_LDA(At, 0, 0); PG8_STAGE(PG8_SA(1, 1), a1 + hstepA, voffA);
            PG8_WAIT_V(8); PG8_WAIT_L(0); PG8_BAR; PG8_MMA(0, 0, At, B0); PG8_MMA(0, 1, At, B1); PG8_BAR; PG8_SCHED;
            PG8_LDA(At, 0, 1); PG8_STAGE(PG8_SB(0, 0), b2, voffB); PG8_STAGE(PG8_SB(0, 1), b2 + hstepB, voffB); PG8_STAGE(PG8_SA(0, 0), a2, voffA);
            PG8_WAIT_V(8); PG8_WAIT_L(0); PG8_BAR; PG8_MMA(1, 0, At, B0); PG8_MMA(1, 1, At, B1); PG8_BAR; PG8_SCHED;
            PG8_LDB(B0, 1, 0); PG8_LDB(B1, 1, 1); PG8_SCHED; PG8_LDA(At, 1, 0); PG8_STAGE(PG8_SA(0, 1), a2 + hstepA, voffA);
            PG8_WAIT_V(8); PG8_WAIT_L(0); PG8_BAR; PG8_MMA(0, 0, At, B0); PG8_MMA(0, 1, At, B1); PG8_BAR; PG8_SCHED;
            PG8_LDA(At, 1, 1); PG8_STAGE(PG8_SB(1, 0), b3, voffB); PG8_STAGE(PG8_SB(1, 1), b3 + hstepB, voffB); PG8_STAGE(PG8_SA(1, 0), a3, voffA);
            PG8_WAIT_V(8); PG8_WAIT_L(0); PG8_BAR; PG8_MMA(1, 0, At, B0); PG8_MMA(1, 1, At, B1); PG8_BAR; PG8_SCHED;
        }
        if (wr == 0) PG8_BAR;
        E(acc, cur, wr, wc, fr, fq);
        if (!has_next) break;
#pragma unroll
        for (int a = 0; a < 2; ++a)
#pragma unroll
            for (int b = 0; b < 2; ++b)
#pragma unroll
                for (int m = 0; m < 4; ++m)
#pragma unroll
                    for (int n = 0; n < 2; ++n) acc[a][b][m][n] = (f32x4){0.f, 0.f, 0.f, 0.f};
        cur = nxt; cA = nA; cB = nB; ++ui;
        if (wr == 1) PG8_BAR;
    }
    PG8_WAIT_V(0);
    PG8_BAR;
#undef PG8_SA
#undef PG8_SB
#undef PG8_STAGE
#undef PG8_LDA
#undef PG8_LDB
#undef PG8_MMA
#undef PG8_WAIT_V
#undef PG8_WAIT_L
#undef PG8_BAR
#undef PG8_SCHED
}
}
template <int MODE> struct EpiOut {
    static constexpr bool SYNC = false;
    bf16_t* O; float* Of; int ldc; const float* rowscale; float s; const float* bias; float* ssq;
    __device__ __forceinline__ void operator()(f32x4 (&acc)[2][2][4][2], const pg8::Unit& u, int wr, int wc, int fr, int fq) const {
        const int row0 = u.pm * 256 + wr * 64 + fr, col0 = u.pn * 256 + wc * 32 + 8 * fq;
        f32x4 bv[2][2];
        if (MODE == 2 || MODE == 3) {
#pragma unroll
            for (int bj = 0; bj < 2; ++bj)
#pragma unroll
                for (int n = 0; n < 2; ++n) bv[bj][n] = *(const f32x4*)(bias + col0 + bj * 128 + 4 * n);
        }
#pragma unroll
        for (int ai = 0; ai < 2; ++ai)
#pragma unroll
            for (int m = 0; m < 4; ++m) {
                const int row = row0 + ai * 128 + m * 16;
                float rs = 1.f; if (MODE == 1) rs = rowscale[row] * s;
                float q = 0.f;
#pragma unroll
                for (int bj = 0; bj < 2; ++bj) {
                    f32x4 v0 = acc[ai][bj][m][0], v1 = acc[ai][bj][m][1];
                    if (MODE == 1) { v0 = v0 * rs; v1 = v1 * rs; }
                    if (MODE == 2) {
                        v0 = v0 + bv[bj][0]; v1 = v1 + bv[bj][1];
#pragma unroll
                        for (int e = 0; e < 4; ++e) {
                            { const float y = -v0[e]; const float sp = fmaxf(y, 0.f) + __logf(1.f + __expf(-fabsf(y))); v0[e] = -__expf(-sp - 0.5f); }
                            { const float y = -v1[e]; const float sp = fmaxf(y, 0.f) + __logf(1.f + __expf(-fabsf(y))); v1[e] = -__expf(-sp - 0.5f); }
                        }
                        float* op = Of + (size_t)row * ldc + col0 + bj * 128;
                        *(f32x4*)op = v0; *(f32x4*)(op + 4) = v1;
                        continue;
                    }
                    if (MODE == 3) {
                        v0 = v0 + bv[bj][0]; v1 = v1 + bv[bj][1];
#pragma unroll
                        for (int e = 0; e < 4; ++e) { v0[e] = fast_sigmoid(v0[e]); v1[e] = fast_sigmoid(v1[e]); }
                    }
                    if (MODE == 4) { q += (v0[0] * v0[0] + v0[1] * v0[1]) + (v0[2] * v0[2] + v0[3] * v0[3]) + (v1[0] * v1[0] + v1[1] * v1[1]) + (v1[2] * v1[2] + v1[3] * v1[3]); }
                    u32x4 w; w.x = cvt_pk_bf16(v0[0], v0[1]); w.y = cvt_pk_bf16(v0[2], v0[3]); w.z = cvt_pk_bf16(v1[0], v1[1]); w.w = cvt_pk_bf16(v1[2], v1[3]);
                    *(u32x4*)(O + (size_t)row * ldc + col0 + bj * 128) = w;
                }
                if (MODE == 4) { q += __shfl_xor(q, 16); q += __shfl_xor(q, 32); if (fq == 0) ssq[(size_t)row * 32 + u.pn * 4 + wc] = q; }
            }
    }
};

struct EpiMulti {
    static constexpr bool SYNC = false;
    int mode; bf16_t* O; float* Of; int ldc; const float* rowscale; float s; const float* bias;
    __device__ __forceinline__ void operator()(f32x4 (&acc)[2][2][4][2], const pg8::Unit& u, int wr, int wc, int fr, int fq) const {
        const int row0 = u.pm * 256 + wr * 64 + fr, col0 = u.pn * 256 + wc * 32 + 8 * fq;
#pragma unroll 1
        for (int ai = 0; ai < 2; ++ai)
#pragma unroll
            for (int m = 0; m < 4; ++m) {
                const int row = row0 + ai * 128 + m * 16;
                const float rs = (mode == 1) ? rowscale[row] * s : 1.f;
#pragma unroll
                for (int bj = 0; bj < 2; ++bj) {
                    f32x4 v0 = ai ? acc[1][bj][m][0] : acc[0][bj][m][0], v1 = ai ? acc[1][bj][m][1] : acc[0][bj][m][1];
                    v0 = v0 * rs; v1 = v1 * rs;
                    if (mode >= 2) { v0 = v0 + *(const f32x4*)(bias + col0 + bj * 128); v1 = v1 + *(const f32x4*)(bias + col0 + bj * 128 + 4); }
                    if (mode == 2) {
#pragma unroll
                        for (int e = 0; e < 4; ++e) {
                            { const float y = -v0[e]; const float sp = fmaxf(y, 0.f) + __logf(1.f + __expf(-fabsf(y))); v0[e] = -__expf(-sp - 0.5f); }
                            { const float y = -v1[e]; const float sp = fmaxf(y, 0.f) + __logf(1.f + __expf(-fabsf(y))); v1[e] = -__expf(-sp - 0.5f); }
                        }
                        float* op = Of + (size_t)row * ldc + col0 + bj * 128;
                        *(f32x4*)op = v0; *(f32x4*)(op + 4) = v1;
                    } else {
                        if (mode == 3) {
#pragma unroll
                            for (int e = 0; e < 4; ++e) { v0[e] = fast_sigmoid(v0[e]); v1[e] = fast_sigmoid(v1[e]); }
                        }
                        u32x4 w; w.x = cvt_pk_bf16(v0[0], v0[1]); w.y = cvt_pk_bf16(v0[2], v0[3]); w.z = cvt_pk_bf16(v1[0], v1[1]); w.w = cvt_pk_bf16(v1[2], v1[3]);
                        *(u32x4*)(O + (size_t)row * ldc + col0 + bj * 128) = w;
                    }
                }
            }
    }
};

__device__ __forceinline__ float gelu_tanh(float x) {
    const float uu = x * (1.f + 0.044715f * x * x);
    return x * __builtin_amdgcn_rcpf(1.f + __builtin_amdgcn_exp2f(-2.f * 0.7978845608f * 1.4426950408889634f * uu));
}
__device__ __forceinline__ float dpp_ror1(float x) { return __int_as_float(__builtin_amdgcn_update_dpp(0, __float_as_int(x), 0x121, 0xf, 0xf, false)); }
__device__ __forceinline__ float dpp_ror2(float x) { return __int_as_float(__builtin_amdgcn_update_dpp(0, __float_as_int(x), 0x122, 0xf, 0xf, false)); }

struct EpiConv {
    static constexpr bool SYNC = true;
    bf16_t* ACT; const float* cw; const float* cb; float* HEADB; float* TAILB; LAS float* TB;
    __device__ __forceinline__ void operator()(f32x4 (&acc)[2][2][4][2], const pg8::Unit& u, int wr, int wc, int fr, int fq) const {
        const int lc0 = 32 * wc + 8 * fq;
        if (fr >= 14) {
            const int rs = fr - 14;
#pragma unroll
            for (int ai = 0; ai < 2; ++ai)
#pragma unroll
                for (int bj = 0; bj < 2; ++bj)
#pragma unroll
                    for (int n = 0; n < 2; ++n) *(LAS f32x4*)(TB + ((ai * 2 + wr) * 2 + rs) * 256 + bj * 128 + lc0 + 4 * n) = acc[ai][bj][3][n];
            if (wr == 1) {
#pragma unroll
                for (int bj = 0; bj < 2; ++bj)
#pragma unroll
                    for (int n = 0; n < 2; ++n) *(f32x4*)(TAILB + ((size_t)u.pm * 2 + rs) * UPW + u.pn * 256 + bj * 128 + lc0 + 4 * n) = acc[1][bj][3][n];
            }
        }
        if (wr == 0 && fr < 2) {
#pragma unroll
            for (int bj = 0; bj < 2; ++bj)
#pragma unroll
                for (int n = 0; n < 2; ++n) *(f32x4*)(HEADB + ((size_t)u.pm * 2 + fr) * UPW + u.pn * 256 + bj * 128 + lc0 + 4 * n) = acc[0][bj][0][n];
        }
        asm volatile("s_waitcnt lgkmcnt(0)" ::: "memory"); __builtin_amdgcn_s_barrier(); asm volatile("" ::: "memory");
        u32x2 pk0[2][4];
#pragma unroll
        for (int n = 0; n < 2; ++n) {
            const int ch = u.pn * 128 + lc0 + 4 * n;
            const f32x4 w0g = *(const f32x4*)(cw + ch), w1g = *(const f32x4*)(cw + UPW + ch), w2g = *(const f32x4*)(cw + 2 * UPW + ch), bg = *(const f32x4*)(cb + ch);
            const f32x4 w0v = *(const f32x4*)(cw + DFF + ch), w1v = *(const f32x4*)(cw + UPW + DFF + ch), w2v = *(const f32x4*)(cw + 2 * UPW + DFF + ch), bvv = *(const f32x4*)(cb + DFF + ch);
#pragma unroll
            for (int ai = 0; ai < 2; ++ai) {
                f32x4 tA[2], tB[2];
                const bool haspred = (wr == 1) || (ai == 1);
                const int pa = (wr == 1) ? ai : 0, pw = (wr == 1) ? 0 : 1;
#pragma unroll
                for (int bj = 0; bj < 2; ++bj) {
                    if (haspred) { tA[bj] = *(const LAS f32x4*)(TB + ((pa * 2 + pw) * 2 + 1) * 256 + bj * 128 + lc0 + 4 * n);
                                   tB[bj] = *(const LAS f32x4*)(TB + ((pa * 2 + pw) * 2 + (fr & 1)) * 256 + bj * 128 + lc0 + 4 * n); }
                    else { tA[bj] = (f32x4){0.f, 0.f, 0.f, 0.f}; tB[bj] = (f32x4){0.f, 0.f, 0.f, 0.f}; }
                }
#pragma unroll
                for (int m = 0; m < 4; ++m) {
                    f32x4 gc, vc;
#pragma unroll
                    for (int e = 0; e < 4; ++e) {
                        const float ug = acc[ai][0][m][n][e], uv = acc[ai][1][m][n][e];
                        float cg1 = dpp_ror1(ug), cg2 = dpp_ror2(ug), cv1 = dpp_ror1(uv), cv2 = dpp_ror2(uv);
                        float qg1 = tA[0][e], qg2 = tB[0][e], qv1 = tA[1][e], qv2 = tB[1][e];
                        if (m > 0) { qg1 = dpp_ror1(acc[ai][0][m > 0 ? m - 1 : 0][n][e]); qg2 = dpp_ror2(acc[ai][0][m > 0 ? m - 1 : 0][n][e]);
                                     qv1 = dpp_ror1(acc[ai][1][m > 0 ? m - 1 : 0][n][e]); qv2 = dpp_ror2(acc[ai][1][m > 0 ? m - 1 : 0][n][e]); }
                        asm volatile("" : "+v"(cg1), "+v"(cg2), "+v"(cv1), "+v"(cv2), "+v"(qg1), "+v"(qg2), "+v"(qv1), "+v"(qv2));
                        const float pg1 = (fr == 0) ? qg1 : cg1, pg2 = (fr < 2) ? qg2 : cg2;
                        const float pv1 = (fr == 0) ? qv1 : cv1, pv2 = (fr < 2) ? qv2 : cv2;
                        gc[e] = fmaf(w0g[e], pg2, fmaf(w1g[e], pg1, fmaf(w2g[e], ug, bg[e])));
                        vc[e] = fmaf(w0v[e], pv2, fmaf(w1v[e], pv1, fmaf(w2v[e], uv, bvv[e])));
                    }
                    u32x2 pk; pk.x = cvt_pk_bf16(gelu_tanh(gc[0]) * vc[0], gelu_tanh(gc[1]) * vc[1]); pk.y = cvt_pk_bf16(gelu_tanh(gc[2]) * vc[2], gelu_tanh(gc[3]) * vc[3]);
                    if (n == 0) pk0[ai][m] = pk;
                    else { const int row = u.pm * 256 + ai * 128 + wr * 64 + m * 16 + fr; u32x4 w; w.x = pk0[ai][m].x; w.y = pk0[ai][m].y; w.z = pk.x; w.w = pk.y;
                           *(u32x4*)(ACT + (size_t)row * DFF + u.pn * 128 + lc0) = w; }
                }
            }
        }
    }
};
constexpr int NWAVES = 8;
constexpr int RING_OFF = 0, RING_BYTES = 131072;
constexpr int TB_OFF = RING_BYTES;
constexpr int LDSCTL_OFF = RING_BYTES + 8192, MISC_OFF = LDSCTL_OFF + 320;
constexpr int LDS_BYTES = 147456;
constexpr int CW_BAR = 4096;
#define RLX_AGENT __ATOMIC_RELAXED, __HIP_MEMORY_SCOPE_AGENT
#define LDS_WAIT() asm volatile("s_waitcnt lgkmcnt(0)" ::: "memory")
#define VM_WAIT() asm volatile("s_waitcnt vmcnt(0)" ::: "memory")

#define XB_TMO      128
#define XB_XCNT(j)  (256  + 64 * (j))
#define XB_XSUB(j)  (1280 + 64 * (j))
#define XB_XGEN(j)  (2304 + 64 * (j))
#define XB_TOP      3328
#define XB_TOPGEN   3392
#define XCD_BAR_WORDS 3456
#define XB_SPIN_CAP (1u << 20)
__device__ __forceinline__ unsigned xb_ld(unsigned* p)              { return __hip_atomic_load(p, __ATOMIC_RELAXED, __HIP_MEMORY_SCOPE_AGENT); }
__device__ __forceinline__ unsigned xb_add(unsigned* p, unsigned v) { return __hip_atomic_fetch_add(p, v, __ATOMIC_RELAXED, __HIP_MEMORY_SCOPE_AGENT); }
__device__ __forceinline__ unsigned xb_xcc_id() { return (unsigned)__builtin_amdgcn_s_getreg((3 << 11) | 20) & 0xFu; }
#define XB_SPIN(cond, bar) do { unsigned _sp = 0; while (cond) { __builtin_amdgcn_s_sleep(1); \
    if ((++_sp & 255u) == 0u) { if (xb_ld(&(bar)[XB_TMO])) break; if (_sp > XB_SPIN_CAP) { atomicAdd(&(bar)[XB_TMO], 1u); break; } } } } while (0)
struct XcdBarrier { unsigned* bar; unsigned x; volatile LAS unsigned* st; };
__device__ __forceinline__ XcdBarrier xcd_barrier_post(unsigned* bar, volatile LAS unsigned* st) {
    XcdBarrier b; b.bar = bar; b.x = xb_xcc_id(); b.st = st;
    if (threadIdx.x == 0) (void)xb_add(&bar[XB_XCNT(b.x)], 1u);
    return b;
}
__device__ __forceinline__ void xcd_barrier_complete(unsigned* bar, unsigned x, unsigned& nloc, unsigned& nx) {
    const unsigned G = gridDim.x * gridDim.y * gridDim.z;
    unsigned sum, cnt, mine, sp = 0u;
    for (;;) {
        sum = 0u; cnt = 0u; mine = 0u;
#pragma unroll
        for (unsigned j = 0; j < 16; ++j) { const unsigned c = xb_ld(&bar[XB_XCNT(j)]); sum += c; cnt += (c > 0u) ? 1u : 0u; mine = (j == x) ? c : mine; }
        if (sum == G) break;
        __builtin_amdgcn_s_sleep(1);
        if ((++sp & 255u) == 0u) { if (xb_ld(&bar[XB_TMO])) break; if (sp > XB_SPIN_CAP) { atomicAdd(&bar[XB_TMO], 1u); break; } }
    }
    nloc = mine > 0u ? mine : 1u; nx = cnt > 0u ? cnt : 1u;
}
__device__ __forceinline__ void xcd_barrier(const XcdBarrier& b) {
    asm volatile("s_waitcnt vmcnt(0)" ::: "memory");
    __syncthreads();
    if (threadIdx.x == 0) {
        unsigned* bar = b.bar;
        __builtin_amdgcn_s_waitcnt(0);
        unsigned nloc = b.st[0], nx = b.st[1];
        if (nloc == 0u) { xcd_barrier_complete(bar, b.x, nloc, nx); b.st[0] = nloc; b.st[1] = nx; }
        const unsigned old = xb_add(&bar[XB_XSUB(b.x)], 1u);
        const unsigned gen = old / nloc;
        if (old + 1u == (gen + 1u) * nloc) {
            __builtin_amdgcn_fence(__ATOMIC_RELEASE, "agent");
            asm volatile("s_waitcnt vmcnt(0)" ::: "memory");
            const unsigned og = xb_add(&bar[XB_TOP], 1u);
            const unsigned tg = og / nx;
            if (og + 1u == (tg + 1u) * nx) xb_add(&bar[XB_TOPGEN], 1u);
            else XB_SPIN(xb_ld(&bar[XB_TOPGEN]) == tg, bar);
            __builtin_amdgcn_fence(__ATOMIC_ACQUIRE, "agent");
            xb_add(&bar[XB_XGEN(b.x)], 1u);
            asm volatile("s_waitcnt vmcnt(0)" ::: "memory");
        } else {
            XB_SPIN(xb_ld(&bar[XB_XGEN(b.x)]) == gen, bar);
            __builtin_amdgcn_fence(__ATOMIC_ACQUIRE, "agent");
            asm volatile("s_waitcnt vmcnt(0)" ::: "memory");
        }
    }
    __syncthreads();
}

struct Frame {
    LAS unsigned char* lds;
    volatile LAS unsigned* MISC;
    gu32* ctl;
    int tid, lane, wave, vcu, G;
    const float* in[30]; float* out; unsigned char* ws;
};
enum { I_X = 0, I_C, I_POS, I_WMOD, I_BMOD, I_GPREMIX, I_WIN, I_MU, I_W0, I_WDEC, I_A0, I_WICLR, I_WGATE, I_KK, I_KA, I_RK, I_LNG, I_LNB, I_QNG, I_WQ, I_KVNG, I_WKV,
       I_WOUT, I_GPOSTMIX, I_GPREFFN, I_WUP, I_CONVW, I_CONVB, I_WDOWN, I_GPOSTFFN };
__constant__ float INV_FREQ[32] = {1.000000000e+00f, 7.498942018e-01f, 5.623413324e-01f, 4.216965139e-01f, 3.162277639e-01f, 2.371373773e-01f, 1.778279394e-01f, 1.333521456e-01f,
    1.000000015e-01f, 7.498942316e-02f, 5.623413250e-02f, 4.216964915e-02f, 3.162277490e-02f, 2.371373773e-02f, 1.778279431e-02f, 1.333521400e-02f, 9.999999776e-03f, 7.498942316e-03f,
    5.623413250e-03f, 4.216964822e-03f, 3.162277630e-03f, 2.371373819e-03f, 1.778279431e-03f, 1.333521446e-03f, 1.000000047e-03f, 7.498941850e-04f, 5.623413017e-04f, 4.216965172e-04f,
    3.162277571e-04f, 2.371373703e-04f, 1.778279402e-04f, 1.333521504e-04f};

__device__ __forceinline__ float modv(const Frame& F, int b, int n) {
    const float* mp = (const float*)(F.ws + WS_MODP) + (size_t)b * 12288 + n;
    return ((mp[0] + mp[4 * 12288]) + (mp[8 * 12288] + mp[12 * 12288])) + F.in[I_BMOD][n];
}

__device__ __forceinline__ void phase_mod(Frame& F) {
    LAS f32x4* sc = (LAS f32x4*)F.lds;
    const float* c = F.in[I_C];
    for (int k = F.tid; k < DM; k += NWAVES * 64) { f32x4 v;
#pragma unroll
        for (int b = 0; b < 4; ++b) { const float x = c[b * DM + k]; v[b] = x * fast_sigmoid(x); }
        sc[k] = v; }
    __syncthreads();
    LAS float* red = (LAS float*)(F.lds + 32768);
    const float* wm = F.in[I_WMOD];
    float* modp = (float*)(F.ws + WS_MODP);
    const int cq = F.lane & 15, rs = F.lane >> 4;
    for (int it = blockIdx.x; it < 768; it += F.G) {
        const int kc = it / 192, nc = it % 192;
        f32x4 acc[4];
#pragma unroll
        for (int b = 0; b < 4; ++b) acc[b] = (f32x4){0.f, 0.f, 0.f, 0.f};
        const int kb = kc * 512 + F.wave * 64 + rs;
#pragma unroll 8
        for (int i = 0; i < 16; ++i) { const int k = kb + 4 * i; const f32x4 w = *(const f32x4*)(wm + (size_t)k * 12288 + nc * 64 + 4 * cq); const f32x4 s = sc[k];
#pragma unroll
            for (int b = 0; b < 4; ++b) acc[b] += w * s[b]; }
#pragma unroll
        for (int b = 0; b < 4; ++b) {
#pragma unroll
            for (int e = 0; e < 4; ++e) { float v = acc[b][e]; v += __shfl_xor(v, 16); v += __shfl_xor(v, 32); acc[b][e] = v; }
            if (rs == 0) *(LAS f32x4*)(red + (F.wave * 4 + b) * 64 + 4 * cq) = acc[b];
        }
        __syncthreads();
        if (F.tid < 256) { const int b = F.tid >> 6, col = F.tid & 63; float s = 0.f;
#pragma unroll
            for (int w = 0; w < 8; ++w) s += red[(w * 4 + b) * 64 + col];
            modp[(size_t)(kc * 4 + b) * 12288 + nc * 64 + col] = s; }
        __syncthreads();
    }
}

__device__ __forceinline__ void transpose_item(const float* W, int N, int Kvalid, const float* kscale, bf16_t* WT, int ldk, int k0, int n0s, int n0d, LAS float* scr, int lane) {
#pragma unroll 8
    for (int i = 0; i < 32; ++i) { const int kk = 2 * i + (lane >> 5), k = k0 + kk; float v = 0.f;
        if (k < Kvalid) { v = W[(size_t)k * N + n0s + (lane & 31)]; if (kscale) v *= kscale[k]; }
        scr[kk * 33 + (lane & 31)] = v; }
    LDS_WAIT(); asm volatile("" ::: "memory");
    const int c = lane & 7;
#pragma unroll
    for (int j = 0; j < 4; ++j) { const int n = (lane >> 3) + 8 * j; const LAS float* s = scr + (8 * c) * 33 + n;
        u32x4 o; o.x = cvt_pk_bf16(s[0 * 33], s[1 * 33]); o.y = cvt_pk_bf16(s[2 * 33], s[3 * 33]); o.z = cvt_pk_bf16(s[4 * 33], s[5 * 33]); o.w = cvt_pk_bf16(s[6 * 33], s[7 * 33]);
        *(u32x4*)(WT + (size_t)(n0d + n) * ldk + k0 + 8 * c) = o; }
    LDS_WAIT(); asm volatile("" ::: "memory");
}
__device__ __forceinline__ void phase_weights(Frame& F) {
    LAS float* scr = (LAS float*)(F.lds + F.wave * 8704);
    const int gw = F.vcu * NWAVES + F.wave, NGW = F.G * NWAVES;
    constexpr int I0 = 32 * 136, I1 = 8 * 48, I2 = 4 * 64, I3 = 32 * 64, I4 = 32 * 352, I5 = 88 * 64, I6 = 2 * 32, I7 = 2 * 32, I8 = 4 * 32;
    constexpr int NITEMS = I0 + I1 + I2 + I3 + I4 + I5 + I6 + I7 + I8;
    for (int it = gw; it < NITEMS; it += NGW) {
        int r = it;
        if (r < I0) { const int kb = r / 136, nb = r % 136; transpose_item(F.in[I_WIN], IN_COLS, DM, nullptr, (bf16_t*)(F.ws + WS_WIN), DM, 64 * kb, 32 * nb, 32 * nb, scr, F.lane); continue; } r -= I0;
        if (r < I1) { const int kb = r / 48, nb = r % 48; transpose_item(F.in[I_WQ], QW, QLR, F.in[I_QNG], (bf16_t*)(F.ws + WS_WQ), QLR, 64 * kb, 32 * nb, 32 * nb, scr, F.lane); continue; } r -= I1;
        if (r < I2) { const int kb = r / 64, nb = r % 64; transpose_item(F.in[I_WKV], KVW, KVLR, F.in[I_KVNG], (bf16_t*)(F.ws + WS_WKV), KVLR, 64 * kb, 32 * nb, 32 * nb, scr, F.lane); continue; } r -= I2;
        if (r < I3) { const int kb = r / 64, nb = r % 64; transpose_item(F.in[I_WOUT], DM, DM, nullptr, (bf16_t*)(F.ws + WS_WOUT), DM, 64 * kb, 32 * nb, 32 * nb, scr, F.lane); continue; } r -= I3;
        if (r < I4) { const int kb = r / 352, nb = r % 352; const int n0d = 32 * nb, pn = n0d >> 8, bj = (n0d >> 7) & 1, j0 = n0d & 127;
                      transpose_item(F.in[I_WUP], UPW, DM, nullptr, (bf16_t*)(F.ws + WS_WUP), DM, 64 * kb, bj * DFF + 128 * pn + j0, n0d, scr, F.lane); continue; } r -= I4;
        if (r < I5) { const int kb = r / 64, nb = r % 64; transpose_item(F.in[I_WDOWN], DM, DFF, nullptr, (bf16_t*)(F.ws + WS_WDOWN), DFF, 64 * kb, 32 * nb, 32 * nb, scr, F.lane); continue; } r -= I5;
        if (r < I6) { const int kb = r / 32, nb = r % 32; transpose_item(F.in[I_WDEC], RW, 96, nullptr, (bf16_t*)(F.ws + WS_WDEC), 128, 64 * kb, 32 * nb, 32 * nb, scr, F.lane); continue; } r -= I6;
        if (r < I7) { const int kb = r / 32, nb = r % 32; transpose_item(F.in[I_WICLR], RW, 96, nullptr, (bf16_t*)(F.ws + WS_WICLR), 128, 64 * kb, 32 * nb, 32 * nb, scr, F.lane); continue; } r -= I7;
        { const int kb = r / 32, nb = r % 32; transpose_item(F.in[I_WGATE], RW, 256, nullptr, (bf16_t*)(F.ws + WS_WGATE), 256, 64 * kb, 32 * nb, 32 * nb, scr, F.lane); }
    }
}
__device__ __forceinline__ void phase_convcopy(Frame& F) {
    float* dst = (float*)(F.ws + WS_CONV);
    const int gt = F.vcu * NWAVES * 64 + F.tid, NT = F.G * NWAVES * 64;
    for (int i = gt; i < 4 * UPW; i += NT) dst[i] = (i < 3 * UPW) ? F.in[I_CONVW][i] : F.in[I_CONVB][i - 3 * UPW];
}
__device__ __forceinline__ void norm_mod_row(const float* xrow, bf16_t* orow, const LAS float* Am, const LAS float* Bm, int lane) {
    const f32x4* xr = (const f32x4*)xrow + lane;
    f32x4 v[8]; float s = 0.f;
#pragma unroll
    for (int j = 0; j < 8; ++j) { v[j] = xr[64 * j]; s += (v[j][0] * v[j][0] + v[j][1] * v[j][1]) + (v[j][2] * v[j][2] + v[j][3] * v[j][3]); }
    const float rstd = rsqrtf(wave_sum(s) * (1.f / DM) + NORM_EPS);
    u32x2* o8 = (u32x2*)orow + lane;
#pragma unroll
    for (int j = 0; j < 8; ++j) { const f32x4 a = *(const LAS f32x4*)(Am + 4 * (lane + 64 * j)), b = *(const LAS f32x4*)(Bm + 4 * (lane + 64 * j));
        const f32x4 y = v[j] * rstd * a + b; u32x2 w; w.x = cvt_pk_bf16(y[0], y[1]); w.y = cvt_pk_bf16(y[2], y[3]); o8[64 * j] = w; }
}
__device__ __forceinline__ void phase_hprep(Frame& F) {
    LAS float* Am = (LAS float*)(F.lds + 73728); LAS float* Bm = (LAS float*)(F.lds + 81920);
    const float* x = F.in[I_X]; bf16_t* H = (bf16_t*)(F.ws + WS_H);
    for (int rb = F.vcu; rb < TOK / 64; rb += F.G) {
        const int b = (rb * 64) / SEQ;
        __syncthreads();
        for (int k = F.tid; k < DM; k += NWAVES * 64) { Am[k] = F.in[I_GPREMIX][k] * (1.f + modv(F, b, 2048 + k)); Bm[k] = modv(F, b, k); }
        __syncthreads();
        for (int rr = F.wave; rr < 64; rr += NWAVES) { const size_t row = (size_t)rb * 64 + rr; norm_mod_row(x + row * DM, H + row * DM, Am, Bm, F.lane); }
    }
}

__device__ __forceinline__ void phase_tokprep(Frame& F) {
    const bf16_t* P = (const bf16_t*)(F.ws + WS_P);
    float* rq = (float*)(F.ws + WS_RSTDQ); float* rkv = (float*)(F.ws + WS_RSTDKV);
    bf16_t* KR = (bf16_t*)(F.ws + WS_KR); f32x2* CS = (f32x2*)(F.ws + WS_CS); bf16_t* LA = (bf16_t*)(F.ws + WS_LA);
    const int* pos = (const int*)F.in[I_POS]; const float* mu = F.in[I_MU];
    const int gw = F.vcu * NWAVES + F.wave, NGW = F.G * NWAVES, lane = F.lane;
    for (int row = gw; row < TOK; row += NGW) {
        const bf16_t* pr = P + (size_t)row * IN_COLS; const bool hp = (row % SEQ) != 0; const bf16_t* pp = pr - IN_COLS;
        { const u32x4 q = *(const u32x4*)(pr + C_QL + lane * 8); float s = 0.f;
#pragma unroll
          for (int i = 0; i < 4; ++i) { const float a = bflo(q[i]), b = bfhi(q[i]); s += a * a + b * b; }
          s = wave_sum(s); if (lane == 0) rq[row] = rsqrtf(s * (1.f / QLR) + NORM_EPS); }
        { const u32x2 q = *(const u32x2*)(pr + C_KVL + lane * 4); float s = 0.f;
#pragma unroll
          for (int i = 0; i < 2; ++i) { const float a = bflo(q[i]), b = bfhi(q[i]); s += a * a + b * b; }
          s = wave_sum(s); if (lane == 0) rkv[row] = rsqrtf(s * (1.f / KVLR) + NORM_EPS); }
        if (lane < 32) {
            const float ang = (float)pos[row] * INV_FREQ[lane];
            double a = (double)ang * 0.15915494309189535; a -= __builtin_rint(a); const float fr = (float)a;
            const float cs = __builtin_amdgcn_cosf(fr), sn = __builtin_amdgcn_sinf(fr);
            const float u1 = bf2f(pr[C_KR + lane]), u2 = bf2f(pr[C_KR + 32 + lane]);
            KR[(size_t)row * 64 + lane] = f2bf(u1 * cs - u2 * sn); KR[(size_t)row * 64 + 32 + lane] = f2bf(u1 * sn + u2 * cs);
            CS[(size_t)row * 32 + lane] = (f32x2){cs, sn};
        }
        bf16_t* la = LA + (size_t)row * LAW;
        if (lane < 48) {
#pragma unroll
            for (int part = 0; part < 2; ++part) { const int c0 = (part ? C_AD : C_WD) + 2 * lane;
                const unsigned cur = *(const unsigned*)(pr + c0); const unsigned prv = hp ? *(const unsigned*)(pp + c0) : 0u;
                const float m0 = mu[c0], m1 = mu[c0 + 1];
                float v0 = bflo(cur), v1 = bfhi(cur); v0 += (bflo(prv) - v0) * m0; v1 += (bfhi(prv) - v1) * m1;
                if (part == 0) { v0 = fast_tanh(v0); v1 = fast_tanh(v1); }
                *(unsigned*)(la + part * 128 + 2 * lane) = cvt_pk_bf16(v0, v1); }
        } else {
            *(unsigned*)(la + 96 + 2 * (lane - 48)) = 0u; *(unsigned*)(la + 128 + 96 + 2 * (lane - 48)) = 0u;
        }
        { const int c0 = C_GD + 4 * lane; const u32x2 cur = *(const u32x2*)(pr + c0); u32x2 prv = (u32x2){0u, 0u}; if (hp) prv = *(const u32x2*)(pp + c0);
          const f32x4 m = *(const f32x4*)(mu + c0);
          float v0 = bflo(cur.x), v1 = bfhi(cur.x), v2 = bflo(cur.y), v3 = bfhi(cur.y);
          v0 += (bflo(prv.x) - v0) * m[0]; v1 += (bfhi(prv.x) - v1) * m[1]; v2 += (bflo(prv.y) - v2) * m[2]; v3 += (bfhi(prv.y) - v3) * m[3];
          u32x2 w; w.x = cvt_pk_bf16(fast_sigmoid(v0), fast_sigmoid(v1)); w.y = cvt_pk_bf16(fast_sigmoid(v2), fast_sigmoid(v3));
          *(u32x2*)(la + 256 + 4 * lane) = w; }
    }
}

__device__ __forceinline__ void phase_mid(Frame& F) {
    LAS float* Gm = (LAS float*)(F.lds + 0); LAS float* Af = (LAS float*)(F.lds + 8192); LAS float* Bf = (LAS float*)(F.lds + 16384);
    const float* x = F.in[I_X]; bf16_t* H = (bf16_t*)(F.ws + WS_H); const bf16_t* O1 = (const bf16_t*)(F.ws + WS_O1); const float* ssq = (const float*)(F.ws + WS_SSQ1);
    const int lane = F.lane;
    for (int rb = F.vcu; rb < TOK / 64; rb += F.G) {
        const int b = (rb * 64) / SEQ;
        __syncthreads();
        for (int k = F.tid; k < DM; k += NWAVES * 64) { Gm[k] = F.in[I_GPOSTMIX][k] * modv(F, b, 4096 + k); Af[k] = F.in[I_GPREFFN][k] * (1.f + modv(F, b, 8192 + k)); Bf[k] = modv(F, b, 6144 + k); }
        __syncthreads();
        for (int rr = F.wave; rr < 64; rr += NWAVES) {
            const size_t row = (size_t)rb * 64 + rr;
            float sq = (lane < 32) ? ssq[row * 32 + lane] : 0.f; sq = wave_sum(sq);
            const float rstd1 = rsqrtf(sq * (1.f / DM) + NORM_EPS);
            const f32x4* xr = (const f32x4*)(x + row * DM) + lane; const u32x2* orow = (const u32x2*)(O1 + row * DM) + lane; f32x4* xo = (f32x4*)(F.out + row * DM) + lane;
            f32x4 v[8]; float s = 0.f;
#pragma unroll
            for (int j = 0; j < 8; ++j) { const f32x4 xv = xr[64 * j]; const u32x2 ov = orow[64 * j]; const f32x4 g = *(const LAS f32x4*)(Gm + 4 * (lane + 64 * j));
                f32x4 o; o[0] = bflo(ov.x); o[1] = bfhi(ov.x); o[2] = bflo(ov.y); o[3] = bfhi(ov.y);
                v[j] = xv + g * (o * rstd1); xo[64 * j] = v[j];
                s += (v[j][0] * v[j][0] + v[j][1] * v[j][1]) + (v[j][2] * v[j][2] + v[j][3] * v[j][3]); }
            const float rstd2 = rsqrtf(wave_sum(s) * (1.f / DM) + NORM_EPS);
            u32x2* o8 = (u32x2*)(H + row * DM) + lane;
#pragma unroll
            for (int j = 0; j < 8; ++j) { const f32x4 a = *(const LAS f32x4*)(Af + 4 * (lane + 64 * j)), bb = *(const LAS f32x4*)(Bf + 4 * (lane + 64 * j));
                const f32x4 y = v[j] * rstd2 * a + bb; u32x2 w; w.x = cvt_pk_bf16(y[0], y[1]); w.y = cvt_pk_bf16(y[2], y[3]); o8[64 * j] = w; }
        }
    }
}

__device__ __forceinline__ void phase_fixup(Frame& F) {
    const float* HEADB = (const float*)(F.ws + WS_HEAD); const float* TAILB = (const float*)(F.ws + WS_TAIL); bf16_t* ACT = (bf16_t*)(F.ws + WS_ACT);
    const float* cw = (const float*)(F.ws + WS_CONV); const float* cb = cw + 3 * UPW;
    const int gt = F.vcu * NWAVES * 64 + F.tid, NT = F.G * NWAVES * 64;
    for (int i = gt; i < 64 * 2 * DFF; i += NT) {
        const int cc = i % DFF, rr = (i / DFF) & 1, pm = i / (2 * DFF);
        if ((pm & 15) == 0) continue;
        const int ng = 256 * (cc >> 7) + (cc & 127), nv = ng + 128;
        const float* h0 = HEADB + ((size_t)pm * 2 + 0) * UPW; const float* h1 = h0 + UPW; const float* t0 = TAILB + ((size_t)(pm - 1) * 2 + 0) * UPW; const float* t1 = t0 + UPW;
        float ug, uv, pg1, pg2, pv1, pv2;
        if (rr == 0) { ug = h0[ng]; uv = h0[nv]; pg1 = t1[ng]; pv1 = t1[nv]; pg2 = t0[ng]; pv2 = t0[nv]; }
        else { ug = h1[ng]; uv = h1[nv]; pg1 = h0[ng]; pv1 = h0[nv]; pg2 = t1[ng]; pv2 = t1[nv]; }
        const float gc = fmaf(cw[cc], pg2, fmaf(cw[UPW + cc], pg1, fmaf(cw[2 * UPW + cc], ug, cb[cc])));
        const float vc = fmaf(cw[DFF + cc], pv2, fmaf(cw[UPW + DFF + cc], pv1, fmaf(cw[2 * UPW + DFF + cc], uv, cb[DFF + cc])));
        ACT[(size_t)(pm * 256 + rr) * DFF + cc] = f2bf(gelu_tanh(gc) * vc);
    }
}

__device__ __forceinline__ void phase_final(Frame& F) {
    LAS float* Gm = (LAS float*)(F.lds + 0);
    const bf16_t* O2 = (const bf16_t*)(F.ws + WS_O2); const float* ssq = (const float*)(F.ws + WS_SSQ2);
    const int lane = F.lane;
    for (int rb = F.vcu; rb < TOK / 64; rb += F.G) {
        const int b = (rb * 64) / SEQ;
        __syncthreads();
        for (int k = F.tid; k < DM; k += NWAVES * 64) Gm[k] = F.in[I_GPOSTFFN][k] * modv(F, b, 10240 + k);
        __syncthreads();
        for (int rr = F.wave; rr < 64; rr += NWAVES) {
            const size_t row = (size_t)rb * 64 + rr;
            float sq = (lane < 32) ? ssq[row * 32 + lane] : 0.f; sq = wave_sum(sq);
            const float rstd = rsqrtf(sq * (1.f / DM) + NORM_EPS);
            const u32x2* orow = (const u32x2*)(O2 + row * DM) + lane; f32x4* xo = (f32x4*)(F.out + row * DM) + lane;
#pragma unroll
            for (int j = 0; j < 8; ++j) { const f32x4 xv = xo[64 * j]; const u32x2 ov = orow[64 * j]; const f32x4 g = *(const LAS f32x4*)(Gm + 4 * (lane + 64 * j));
                f32x4 o; o[0] = bflo(ov.x); o[1] = bfhi(ov.x); o[2] = bflo(ov.y); o[3] = bfhi(ov.y);
                xo[64 * j] = xv + g * (o * rstd); }
        }
    }
}
namespace att {
constexpr int NW = 8, QBLK = 32, KVBLK = 64;
constexpr int SHM_V = 16384, SHM_K = 16384, SHM_KR = 8192;
constexpr int OFF_V = 0, OFF_K = 2 * SHM_V, OFF_KR = OFF_K + 2 * SHM_K, OFF_WS = OFF_KR + 2 * SHM_KR, SHM_ATTN = OFF_WS + NW * 64 * 4;
constexpr float THR = 8.f;
#define KSWZ(row, colB) ((row) * 256 + ((colB) ^ (((row) & 7) << 4)))
#define KRSWZ(row, colB) ((row) * 128 + ((colB) ^ ((((row) >> 1) & 7) << 4)))
#define SBAR() __builtin_amdgcn_sched_barrier(0)
__device__ __forceinline__ int crow(int r, int hi) { return (r & 3) + 8 * (r >> 2) + 4 * hi; }
__device__ __forceinline__ void partialSM(f32x16& p0, f32x16& p1, float& m_reg, float& mn, float& alpha) {
    float pmax = p0[0];
#pragma unroll
    for (int r = 1; r < 16; ++r) pmax = fmaxf(pmax, p0[r]);
#pragma unroll
    for (int r = 0; r < 16; ++r) pmax = fmaxf(pmax, p1[r]);
    { auto rr = __builtin_amdgcn_permlane32_swap(__float_as_uint(pmax), __float_as_uint(pmax), false, false);
      pmax = fmaxf(__uint_as_float(rr[0]), __uint_as_float(rr[1])); }
    if (__builtin_expect(__all(pmax - m_reg <= THR), 1)) { mn = m_reg; alpha = 1.f; }
    else { mn = fmaxf(m_reg, pmax); alpha = __builtin_amdgcn_exp2f(m_reg - mn); m_reg = mn; }
#pragma unroll
    for (int r = 0; r < 16; ++r) { p0[r] = p0[r] - mn; p1[r] = p1[r] - mn; }
#pragma unroll
    for (int r = 0; r < 16; ++r) p0[r] = __builtin_amdgcn_exp2f(p0[r]);
}
__device__ __forceinline__ void finishSM(f32x16& p0, f32x16& p1, float alpha, float& l_reg, bf16x8& pa0, bf16x8& pa1, bf16x8& pa2, bf16x8& pa3) {
#pragma unroll
    for (int r = 0; r < 16; ++r) p1[r] = __builtin_amdgcn_exp2f(p1[r]);
    float ps = 0;
#pragma unroll
    for (int r = 0; r < 16; ++r) ps += p0[r];
#pragma unroll
    for (int r = 0; r < 16; ++r) ps += p1[r];
    { auto rr = __builtin_amdgcn_permlane32_swap(__float_as_uint(ps), __float_as_uint(ps), false, false);
      ps = __uint_as_float(rr[0]) + __uint_as_float(rr[1]); }
    l_reg = l_reg * alpha + ps;
#define PK4(P, BASE, OUT) do { unsigned a0 = cvt_pk_bf16(P[BASE + 0], P[BASE + 1]), a1 = cvt_pk_bf16(P[BASE + 2], P[BASE + 3]);   \
    unsigned b0 = cvt_pk_bf16(P[BASE + 4], P[BASE + 5]), b1 = cvt_pk_bf16(P[BASE + 6], P[BASE + 7]);                              \
    auto r0 = __builtin_amdgcn_permlane32_swap(a0, b0, false, false); auto r1 = __builtin_amdgcn_permlane32_swap(a1, b1, false, false); \
    u32x4 w = {r0[0], r1[0], r0[1], r1[1]}; OUT = *reinterpret_cast<bf16x8*>(&w); } while (0)
    PK4(p0, 0, pa0); PK4(p0, 8, pa1); PK4(p1, 0, pa2); PK4(p1, 8, pa3);
#undef PK4
}
__device__ __forceinline__ void qkt(f32x16& p0, f32x16& p1, const char* Ks, const char* KRs, const bf16x8* qr, int r32, int hi) {
    p0 = f32x16{}; p1 = f32x16{};
#pragma unroll
    for (int d0 = 0; d0 < 8; ++d0) { const int cb = (d0 * 16 + hi * 8) * 2;
        const bf16x8 b0 = *reinterpret_cast<const bf16x8*>(Ks + KSWZ(r32, cb));
        const bf16x8 b1 = *reinterpret_cast<const bf16x8*>(Ks + KSWZ(32 + r32, cb));
        p0 = __builtin_amdgcn_mfma_f32_32x32x16_bf16(b0, qr[d0], p0, 0, 0, 0);
        p1 = __builtin_amdgcn_mfma_f32_32x32x16_bf16(b1, qr[d0], p1, 0, 0, 0); }
#pragma unroll
    for (int d0 = 0; d0 < 4; ++d0) { const int cb = (d0 * 16 + hi * 8) * 2;
        const bf16x8 b0 = *reinterpret_cast<const bf16x8*>(KRs + KRSWZ(r32, cb));
        const bf16x8 b1 = *reinterpret_cast<const bf16x8*>(KRs + KRSWZ(32 + r32, cb));
        p0 = __builtin_amdgcn_mfma_f32_32x32x16_bf16(b0, qr[8 + d0], p0, 0, 0, 0);
        p1 = __builtin_amdgcn_mfma_f32_32x32x16_bf16(b1, qr[8 + d0], p1, 0, 0, 0); }
}
__device__ __forceinline__ int v_st(int k, int c) { const int kk = (k & ~0xC) | ((k & 4) << 1) | ((k & 8) >> 1); return ((kk >> 3) * 4 + (c >> 5)) * 512 + ((kk & 7) * 32 + (c & 31)) * 2; }
__device__ __forceinline__ int v_rd_base(int lane) { return ((lane & 3) << 3) | (((lane >> 2) & 3) << 6) | (((lane >> 4) & 1) << 5) | (((lane >> 5) & 1) << 8); }
constexpr int v_rd_off(int d0, int ks, int half) { return d0 * 512 + ks * 4096 + half * 2048; }
template <int OFF> __device__ __forceinline__ s16x4 tr_read(int vb) {
    s16x4 r; asm volatile("ds_read_b64_tr_b16 %0, %1 offset:%2" : "=&v"(r) : "v"(vb), "i"(OFF) : "memory"); return r;
}
template <int D0> __device__ __forceinline__ void pv_one(f32x16& od, int vb, bf16x8 pa0, bf16x8 pa1, bf16x8 pa2, bf16x8 pa3) {
    const s16x4 l0 = tr_read<v_rd_off(D0, 0, 0)>(vb), h0 = tr_read<v_rd_off(D0, 0, 1)>(vb), l1 = tr_read<v_rd_off(D0, 1, 0)>(vb), h1 = tr_read<v_rd_off(D0, 1, 1)>(vb);
    const s16x4 l2 = tr_read<v_rd_off(D0, 2, 0)>(vb), h2 = tr_read<v_rd_off(D0, 2, 1)>(vb), l3 = tr_read<v_rd_off(D0, 3, 0)>(vb), h3 = tr_read<v_rd_off(D0, 3, 1)>(vb);
    asm volatile("s_waitcnt lgkmcnt(0)" ::: "memory"); SBAR();
#define PK(L, H) (bf16x8){L[0], L[1], L[2], L[3], H[0], H[1], H[2], H[3]}
    od = __builtin_amdgcn_mfma_f32_32x32x16_bf16(pa0, PK(l0, h0), od, 0, 0, 0);
    od = __builtin_amdgcn_mfma_f32_32x32x16_bf16(pa1, PK(l1, h1), od, 0, 0, 0);
    od = __builtin_amdgcn_mfma_f32_32x32x16_bf16(pa2, PK(l2, h2), od, 0, 0, 0);
    od = __builtin_amdgcn_mfma_f32_32x32x16_bf16(pa3, PK(l3, h3), od, 0, 0, 0);
#undef PK
}
__device__ __forceinline__ void pv_d0(f32x16* o, int vb, bf16x8 pa0, bf16x8 pa1, bf16x8 pa2, bf16x8 pa3) {
    pv_one<0>(o[0], vb, pa0, pa1, pa2, pa3); pv_one<1>(o[1], vb, pa0, pa1, pa2, pa3); pv_one<2>(o[2], vb, pa0, pa1, pa2, pa3); pv_one<3>(o[3], vb, pa0, pa1, pa2, pa3);
}

__device__ __forceinline__ void attn_unit(int b, int h, int qb, const bf16_t* __restrict__ Qg, const bf16_t* __restrict__ KVg, const bf16_t* __restrict__ KRg, const f32x2* __restrict__ CSg,
                                          bf16_t* __restrict__ Yg, char* lds) {
    const int tid = threadIdx.x, wid = __builtin_amdgcn_readfirstlane(tid >> 6), lane = tid & 63, r32 = lane & 31, hi = lane >> 5;
    char* V_lds = lds + OFF_V; char* K_lds = lds + OFF_K; char* KR_lds = lds + OFF_KR;
    float* ws = (float*)(lds + OFF_WS) + wid * 64; float* li_l = ws; float* al_l = ws + 32;
    const int q0 = qb * 256, NT = 4 * qb + 4, nt_w = 4 * qb + (wid >> 1) + 1;
    const size_t tok0 = (size_t)b * SEQ;
    float m_reg = -1e30f, l_reg = 0; f32x16 o[4] = {}; bf16x8 qr[12];
    { const size_t qrow = tok0 + q0 + wid * QBLK + r32;
      const bf16_t* Qw = Qg + qrow * QW + h * QHD + hi * 8;
#pragma unroll
      for (int d0 = 0; d0 < 12; ++d0) qr[d0] = *reinterpret_cast<const bf16x8*>(Qw + d0 * 16);
      const f32x2* cs = CSg + qrow * 32 + hi * 8;
#pragma unroll
      for (int dd = 0; dd < 2; ++dd) {
          bf16x8 x1 = qr[8 + dd], x2 = qr[10 + dd]; float y1[8], y2[8];
#pragma unroll
          for (int j = 0; j < 8; ++j) { const f32x2 c = cs[dd * 16 + j]; const float a = bf2f((unsigned short)x1[j]), bb = bf2f((unsigned short)x2[j]);
              y1[j] = a * c[0] - bb * c[1]; y2[j] = a * c[1] + bb * c[0]; }
          u32x4 w1 = {cvt_pk_bf16(y1[0], y1[1]), cvt_pk_bf16(y1[2], y1[3]), cvt_pk_bf16(y1[4], y1[5]), cvt_pk_bf16(y1[6], y1[7])};
          u32x4 w2 = {cvt_pk_bf16(y2[0], y2[1]), cvt_pk_bf16(y2[2], y2[3]), cvt_pk_bf16(y2[4], y2[5]), cvt_pk_bf16(y2[6], y2[7])};
          qr[8 + dd] = *reinterpret_cast<bf16x8*>(&w1); qr[10 + dd] = *reinterpret_cast<bf16x8*>(&w2);
      } }
    const bf16_t* Kh = KVg + tok0 * KVW + h * 256; const bf16_t* Vh = Kh + 128; const bf16_t* KRb = KRg + tok0 * 64;
    const int sr = tid >> 4, sc = (tid & 15) * 8, vst0 = v_st(sr, sc), vst1 = v_st(32 + sr, sc);
    const int krr = tid >> 3, krc = (tid & 7) * 8;
    const int vb0 = (int)(uintptr_t)V_lds + v_rd_base(lane);
    bf16x8 s_vs0, s_vs1, s_ks0, s_ks1, s_kr;
#define SLOAD(k0) do { s_vs0 = *reinterpret_cast<const bf16x8*>(&Vh[(size_t)((k0) + sr) * KVW + sc]); s_vs1 = *reinterpret_cast<const bf16x8*>(&Vh[(size_t)((k0) + 32 + sr) * KVW + sc]); \
    s_ks0 = *reinterpret_cast<const bf16x8*>(&Kh[(size_t)((k0) + sr) * KVW + sc]); s_ks1 = *reinterpret_cast<const bf16x8*>(&Kh[(size_t)((k0) + 32 + sr) * KVW + sc]); \
    s_kr = *reinterpret_cast<const bf16x8*>(&KRb[(size_t)((k0) + krr) * 64 + krc]); } while (0)
#define SWRITE(bb) do { *(bf16x8*)(V_lds + (bb) * SHM_V + vst0) = s_vs0; *(bf16x8*)(V_lds + (bb) * SHM_V + vst1) = s_vs1; const int kc = sc * 2; \
    *(bf16x8*)(K_lds + (bb) * SHM_K + KSWZ(sr, kc)) = s_ks0; *(bf16x8*)(K_lds + (bb) * SHM_K + KSWZ(32 + sr, kc)) = s_ks1; \
    *(bf16x8*)(KR_lds + (bb) * SHM_KR + KRSWZ(krr, krc * 2)) = s_kr; } while (0)
#define SWAIT() asm volatile("s_waitcnt vmcnt(0)" ::: "memory")
#define RESC(a) do { if (__any((a) < 1.f)) { if (hi == 0) al_l[r32] = (a); asm volatile("s_waitcnt lgkmcnt(0)" ::: "memory"); \
    _Pragma("unroll") for (int d = 0; d < 4; ++d) _Pragma("unroll") for (int r = 0; r < 16; ++r) o[d][r] *= al_l[crow(r, hi)]; } } while (0)
#define ACTV(j) ((j) < nt_w)
    f32x16 p0, p1; float mn, al = 1.f; bf16x8 pa0, pa1, pa2, pa3;
    SLOAD(0); SWAIT(); SWRITE(0); __syncthreads();
    for (int j = 0; j < NT; ++j) {
        const int bsel = j & 1;
        if (j + 1 < NT) SLOAD((j + 1) * KVBLK);
        if (ACTV(j)) {
            qkt(p0, p1, K_lds + bsel * SHM_K, KR_lds + bsel * SHM_KR, qr, r32, hi);
            partialSM(p0, p1, m_reg, mn, al);
            RESC(al);
            finishSM(p0, p1, al, l_reg, pa0, pa1, pa2, pa3); SBAR();
            pv_d0(o, vb0 + bsel * SHM_V, pa0, pa1, pa2, pa3);
        }
        if (j + 1 < NT) { SWAIT(); SWRITE(bsel ^ 1); }
        __syncthreads();
    }
    if (hi == 0) li_l[r32] = l_reg; asm volatile("s_waitcnt lgkmcnt(0)" ::: "memory");
    float rli[16];
#pragma unroll
    for (int r = 0; r < 16; ++r) rli[r] = __builtin_amdgcn_rcpf(li_l[crow(r, hi)]);
    bf16_t* Yw = Yg + (tok0 + q0 + wid * QBLK) * DM + RW + h * DV;
#pragma unroll
    for (int r = 0; r < 16; ++r) { const int orow = crow(r, hi);
#pragma unroll
        for (int d0 = 0; d0 < 4; ++d0) Yw[(size_t)orow * DM + d0 * 32 + r32] = f2bf(o[d0][r] * rli[r]); }
    __syncthreads();
#undef SLOAD
#undef SWRITE
#undef SWAIT
#undef RESC
#undef ACTV
}
#undef SBAR
}
__device__ __forceinline__ void phase_rwkv_seq(Frame& F, const float* LD, const bf16_t* Ab, const bf16_t* Gb) {
    if (F.wave != 0) return;
    const bf16_t* P = (const bf16_t*)(F.ws + WS_P); bf16_t* Y = (bf16_t*)(F.ws + WS_YCAT);
    const int lane = F.lane;
    LAS float* raw = (LAS float*)F.lds;
    LAS float* vec = (LAS float*)(F.lds + 24576);
    for (int item = blockIdx.x; item < NB * RH; item += F.G) {
        const int b = item / RH, h = item % RH, col = h * RN + lane;
        const float mu_r = F.in[I_MU][C_R + col], mu_k = F.in[I_MU][C_K + col], mu_v = F.in[I_MU][C_V + col];
        const float kkw = F.in[I_KK][col], kaw = F.in[I_KA][col], rkw = F.in[I_RK][col], lng = F.in[I_LNG][col], lnb = F.in[I_LNB][col];
        float S[64];
#pragma unroll
        for (int k = 0; k < 64; ++k) S[k] = 0.f;
        for (int t0 = 0; t0 < SEQ; t0 += 16) {
#pragma unroll
            for (int tt = 0; tt < 16; ++tt) {
                const size_t row = (size_t)b * SEQ + t0 + tt; const bf16_t* pr = P + row * IN_COLS; const bool hp = (t0 + tt) > 0;
                const float cr = bf2f(pr[C_R + col]), ck = bf2f(pr[C_K + col]), cv = bf2f(pr[C_V + col]);
                const float qr_ = hp ? bf2f(pr[C_R + col - IN_COLS]) : 0.f, qk_ = hp ? bf2f(pr[C_K + col - IN_COLS]) : 0.f, qv_ = hp ? bf2f(pr[C_V + col - IN_COLS]) : 0.f;
                raw[(tt * 6 + 0) * 64 + lane] = cr + (qr_ - cr) * mu_r;
                raw[(tt * 6 + 1) * 64 + lane] = ck + (qk_ - ck) * mu_k;
                raw[(tt * 6 + 2) * 64 + lane] = cv + (qv_ - cv) * mu_v;
                raw[(tt * 6 + 3) * 64 + lane] = LD[row * RW + col];
                raw[(tt * 6 + 4) * 64 + lane] = bf2f(Ab[row * RW + col]);
                raw[(tt * 6 + 5) * 64 + lane] = bf2f(Gb[row * RW + col]);
            }
            for (int tt = 0; tt < 16; ++tt) {
                const float r = raw[(tt * 6 + 0) * 64 + lane], k = raw[(tt * 6 + 1) * 64 + lane], ld = raw[(tt * 6 + 3) * 64 + lane], a = raw[(tt * 6 + 4) * 64 + lane];
                const float kkx = k * kkw; const float ss = wave_sum(kkx * kkx); const float kk = kkx / fmaxf(sqrtf(ss), 1e-12f);
                const float kmod = k * (1.f + (a - 1.f) * kaw);
                const float bon = wave_sum(r * kmod * rkw);
                vec[(tt * 5 + 0) * 64 + lane] = r; vec[(tt * 5 + 1) * 64 + lane] = __expf(ld); vec[(tt * 5 + 2) * 64 + lane] = kmod;
                vec[(tt * 5 + 3) * 64 + lane] = -kk; vec[(tt * 5 + 4) * 64 + lane] = kk * a;
                raw[(tt * 6 + 3) * 64 + lane] = bon;
            }
            for (int tt = 0; tt < 16; ++tt) {
                const LAS float* vr = vec + (tt * 5 + 0) * 64; const LAS float* vw = vr + 64; const LAS float* vk = vr + 128; const LAS float* vn = vr + 192; const LAS float* vb = vr + 256;
                const float v = raw[(tt * 6 + 2) * 64 + lane], bon = raw[(tt * 6 + 3) * 64 + lane], g = raw[(tt * 6 + 5) * 64 + lane];
                float sa = 0.f;
#pragma unroll
                for (int k = 0; k < 64; ++k) sa = fmaf(S[k], vn[k], sa);
                float y = 0.f;
#pragma unroll
                for (int k = 0; k < 64; ++k) { S[k] = fmaf(S[k], vw[k], fmaf(sa, vb[k], v * vk[k])); y = fmaf(S[k], vr[k], y); }
                const float mean = wave_sum(y) * (1.f / 64.f); const float d = y - mean; const float var = wave_sum(d * d) * (1.f / 64.f);
                const float yn = d * rsqrtf(var + GN_EPS) * lng + lnb;
                const size_t row = (size_t)b * SEQ + t0 + tt;
                Y[row * DM + col] = f2bf((yn + bon * v) * g);
            }
        }
    }
}
constexpr int N_PHASES = 13;
struct Args { const void* in[30]; float* out; unsigned char* ws; int ph_lo, ph_hi, li, pad; };
__global__ void __launch_bounds__(NWAVES * 64, 2) mk_fwd(Args args) {
    extern __shared__ __attribute__((aligned(16))) unsigned char lds[];
    Frame F;
    F.lds = (LAS unsigned char*)lds;
    F.MISC = (volatile LAS unsigned*)(F.lds + MISC_OFF);
    F.tid = threadIdx.x; F.lane = F.tid & 63; F.wave = __builtin_amdgcn_readfirstlane(F.tid >> 6);
    F.G = gridDim.x; { const int bx = blockIdx.x; F.vcu = (F.G % 8 == 0) ? (bx % 8) * (F.G / 8) + bx / 8 : bx; }
    F.ws = args.ws; F.out = args.out; F.ctl = (gu32*)(args.ws + WS_CTL);
#pragma unroll
    for (int i = 0; i < 30; ++i) F.in[i] = (const float*)args.in[i];
    for (int u = F.tid; u < (LDS_BYTES - LDSCTL_OFF) / 4; u += NWAVES * 64) ((LAS unsigned*)(F.lds + LDSCTL_OFF))[u] = 0u;
    __syncthreads();
    XcdBarrier bar; bar.bar = (unsigned*)(F.ctl + CW_BAR); bar.x = 0; bar.st = nullptr;
#if MK_ONE_LAUNCH
    bar = xcd_barrier_post((unsigned*)(F.ctl + CW_BAR), F.MISC + 8);
#define GRID_BAR() xcd_barrier(bar)
#else
#define GRID_BAR() do { } while (0)
#endif
    const int lo = args.ph_lo, hi = args.ph_hi;
#ifndef P4SEL
#define P4SEL 31
#endif
#ifndef MK_FLIP
#define MK_FLIP 0
#endif
#ifndef PH_MASK
#define PH_MASK 0x1fff
#endif
#define IN(k) (((PH_MASK >> (k)) & 1) && lo <= (k) && (k) < hi)
#define SEAM(k) do { if (IN(k) && IN((k) + 1)) GRID_BAR(); } while (0)
    float* LD = args.out; bf16_t* Ab = (bf16_t*)((char*)args.out + 64 * MiB); bf16_t* Gb = (bf16_t*)((char*)args.out + 96 * MiB);

    if (IN(0)) { phase_mod(F); SEAM(0); }
    if (IN(1)) { phase_weights(F); phase_convcopy(F); phase_hprep(F); SEAM(1); }
    if (IN(2)) {
        pg8::Gemm g{(const bf16_t*)(F.ws + WS_H), (const bf16_t*)(F.ws + WS_WIN), TOK, IN_COLS, DM, DM, DM};
        pg8::StaticOrder S; S.init(TOK, IN_COLS, F.G, (int)blockIdx.x);
        EpiOut<0> E{(bf16_t*)(F.ws + WS_P), nullptr, IN_COLS, nullptr, 1.f, nullptr, nullptr};
        pg8::gemm_phase(F.lds + RING_OFF, g, S, E);
        SEAM(2);
    }
    if (IN(3)) { phase_tokprep(F); SEAM(3); }
    if (IN(4)) {
#pragma unroll 1
        for (int gi = 0; gi < 5; ++gi) {
            if (!((P4SEL >> gi) & 1)) continue;
            pg8::Gemm g; EpiMulti E;
            const bf16_t* Pb = (const bf16_t*)(F.ws + WS_P); const bf16_t* LAb = (const bf16_t*)(F.ws + WS_LA);
            if (gi == 0)      { g = pg8::Gemm{Pb + C_QL, (const bf16_t*)(F.ws + WS_WQ), TOK, QW, QLR, IN_COLS, QLR};
                                E = EpiMulti{1, (bf16_t*)(F.ws + WS_Q), nullptr, QW, (const float*)(F.ws + WS_RSTDQ), 0.07216878364870322f * 1.4426950408889634f, nullptr}; }
            else if (gi == 1) { g = pg8::Gemm{Pb + C_KVL, (const bf16_t*)(F.ws + WS_WKV), TOK, KVW, KVLR, IN_COLS, KVLR};
                                E = EpiMulti{1, (bf16_t*)(F.ws + WS_KV), nullptr, KVW, (const float*)(F.ws + WS_RSTDKV), 1.f, nullptr}; }
            else if (gi == 2) { g = pg8::Gemm{LAb, (const bf16_t*)(F.ws + WS_WDEC), TOK, RW, 128, LAW, 128};
                                E = EpiMulti{2, nullptr, LD, RW, nullptr, 1.f, F.in[I_W0]}; }
            else if (gi == 3) { g = pg8::Gemm{LAb + 128, (const bf16_t*)(F.ws + WS_WICLR), TOK, RW, 128, LAW, 128};
                                E = EpiMulti{3, Ab, nullptr, RW, nullptr, 1.f, F.in[I_A0]}; }
            else              { g = pg8::Gemm{LAb + 256, (const bf16_t*)(F.ws + WS_WGATE), TOK, RW, 256, LAW, 256};
                                E = EpiMulti{0, Gb, nullptr, RW, nullptr, 1.f, nullptr}; }
            pg8::StaticOrder S; S.init(g.M, g.N, F.G, (int)blockIdx.x);
            pg8::gemm_phase(F.lds + RING_OFF, g, S, E);
        }
        SEAM(4);
    }
    if (IN(5)) { phase_rwkv_seq(F, LD, Ab, Gb); SEAM(5); }
    if (IN(6)) {
        for (int u = F.vcu; u < 256; u += F.G) {
            const int bh = u >> 3, s = u & 7, b = bh >> 3, h = bh & 7;
#pragma unroll 1
            for (int it2 = 0; it2 < 2; ++it2)
                att::attn_unit(b, h, it2 ? 15 - s : s, (const bf16_t*)(F.ws + WS_Q), (const bf16_t*)(F.ws + WS_KV), (const bf16_t*)(F.ws + WS_KR), (const f32x2*)(F.ws + WS_CS), (bf16_t*)(F.ws + WS_YCAT), (char*)lds);
        }
        SEAM(6);
    }
    if (IN(7)) {
        pg8::Gemm g{(const bf16_t*)(F.ws + WS_YCAT), (const bf16_t*)(F.ws + WS_WOUT), TOK, DM, DM, DM, DM};
        pg8::StaticOrder S; S.init(TOK, DM, F.G, (int)blockIdx.x);
        EpiOut<4> E{(bf16_t*)(F.ws + WS_O1), nullptr, DM, nullptr, 1.f, nullptr, (float*)(F.ws + WS_SSQ1)};
        pg8::gemm_phase(F.lds + RING_OFF, g, S, E);
        SEAM(7);
    }
    if (IN(8)) { phase_mid(F); SEAM(8); }
    if (IN(9)) {
        pg8::Gemm g{(const bf16_t*)(F.ws + WS_H), (const bf16_t*)(F.ws + WS_WUP), TOK, UPW, DM, DM, DM};
        pg8::StaticOrder S; S.init(TOK, UPW, F.G, (int)blockIdx.x); S.flip = MK_FLIP;
        EpiConv E{(bf16_t*)(F.ws + WS_ACT), (const float*)(F.ws + WS_CONV), (const float*)(F.ws + WS_CONV) + 3 * UPW, (float*)(F.ws + WS_HEAD), (float*)(F.ws + WS_TAIL), (LAS float*)(F.lds + TB_OFF)};
        pg8::gemm_phase(F.lds + RING_OFF, g, S, E);
        SEAM(9);
    }
    if (IN(10)) { phase_fixup(F); SEAM(10); }
    if (IN(11)) {
        pg8::Gemm g{(const bf16_t*)(F.ws + WS_ACT), (const bf16_t*)(F.ws + WS_WDOWN), TOK, DM, DFF, DFF, DFF};
        pg8::StaticOrder S; S.init(TOK, DM, F.G, (int)blockIdx.x);
        EpiOut<4> E{(bf16_t*)(F.ws + WS_O2), nullptr, DM, nullptr, 1.f, nullptr, (float*)(F.ws + WS_SSQ2)};
        pg8::gemm_phase(F.lds + RING_OFF, g, S, E);
        SEAM(11);
    }
    if (IN(12)) { phase_final(F); }
#undef IN
#undef SEAM
}

#if MK_CHECK
#ifndef MK_RPT
#define MK_RPT 0
#endif
__device__ __forceinline__ unsigned hsh(unsigned x) { x ^= x >> 16; x *= 0x7feb352dU; x ^= x >> 15; x *= 0x846ca68bU; x ^= x >> 16; return x; }
__device__ __forceinline__ bool bad(float got, float ref, float rtol, float atol) { return !(fabsf(got - ref) <= atol + rtol * fabsf(ref)); }
__device__ float d_modv(const unsigned char* ws, const float* bmod, int b, int n) {
    const float* mp = (const float*)(ws + WS_MODP) + (size_t)b * 12288 + n;
    return ((mp[0] + mp[4 * 12288]) + (mp[8 * 12288] + mp[12 * 12288])) + bmod[n];
}
__global__ void chk(int phase, Args a) {
    const float* const* in = (const float* const*)a.in; unsigned char* ws = a.ws; unsigned* flag = (unsigned*)(ws + WS_CTL) + 8;
    const int tid = threadIdx.x; const unsigned h0 = hsh(tid * 7919u + phase * 104729u + 12345u);
    const bf16_t* P = (const bf16_t*)(ws + WS_P);
    int row = (int)(h0 % TOK);
    if ((tid & 7) == 1) row = (row & ~255); if ((tid & 7) == 2) row = (row & ~255) + 1; if ((tid & 7) == 3) row = (row | 255); if ((tid & 7) == 4) row = (row & ~63); if ((tid & 7) == 5) row = (row & ~15);
    const int b = row / SEQ, t = row % SEQ;
    const unsigned h1 = hsh(h0);
    bool f = false; int bit = 0;
    if (phase == 0) {
        bit = 1; const int n = h1 % 12288; const int bb = tid & 3; float s = 0.f;
        for (int k = 0; k < DM; ++k) { const float x = in[I_C][bb * DM + k]; s += x / (1.f + expf(-x)) * in[I_WMOD][(size_t)k * 12288 + n]; }
        s += in[I_BMOD][n]; f = bad(d_modv(ws, in[I_BMOD], bb, n), s, 1e-3f, 1e-3f);
    } else if (phase == 1) {
        bit = 2; const int c = h1 % DM; float ss = 0.f; const float* xr = in[I_X] + (size_t)row * DM;
        for (int k = 0; k < DM; ++k) ss += xr[k] * xr[k];
        const float ref = xr[c] * rsqrtf(ss / DM + NORM_EPS) * in[I_GPREMIX][c] * (1.f + d_modv(ws, in[I_BMOD], b, 2048 + c)) + d_modv(ws, in[I_BMOD], b, c);
        f = bad(bf2f(((const bf16_t*)(ws + WS_H))[(size_t)row * DM + c]), ref, 0.01f, 0.01f);
    } else if (phase == 2) {
        bit = 3; int c = h1 % IN_COLS; if ((tid & 15) == 9) c = IN_COLS - 1 - (tid >> 4); const bf16_t* hr = (const bf16_t*)(ws + WS_H) + (size_t)row * DM; float s = 0.f;
        for (int k = 0; k < DM; ++k) s += bf2f(hr[k]) * in[I_WIN][(size_t)k * IN_COLS + c];
        f = bad(bf2f(P[(size_t)row * IN_COLS + c]), s, 0.02f, 0.02f);
    } else if (phase == 4) {
        const bf16_t* pr = P + (size_t)row * IN_COLS;
        { bit = 4; const int c = h1 % QW; float ss = 0.f, s = 0.f;
          for (int k = 0; k < QLR; ++k) { const float v = bf2f(pr[C_QL + k]); ss += v * v; s += v * in[I_QNG][k] * in[I_WQ][(size_t)k * QW + c]; }
          s *= rsqrtf(ss / QLR + NORM_EPS) * 0.07216878364870322f * 1.4426950408889634f;
          if (bad(bf2f(((const bf16_t*)(ws + WS_Q))[(size_t)row * QW + c]), s, 0.03f, 0.01f)) atomicOr(flag, 1u << 4); }
        { const int c = h1 % KVW; float ss = 0.f, s = 0.f;
          for (int k = 0; k < KVLR; ++k) { const float v = bf2f(pr[C_KVL + k]); ss += v * v; s += v * in[I_KVNG][k] * in[I_WKV][(size_t)k * KVW + c]; }
          s *= rsqrtf(ss / KVLR + NORM_EPS);
          if (bad(bf2f(((const bf16_t*)(ws + WS_KV))[(size_t)row * KVW + c]), s, 0.03f, 0.01f)) atomicOr(flag, 1u << 5); }
        { const int j = h1 % 32; const float ang = (float)((const int*)in[I_POS])[row] * powf(10000.f, -(float)j / 32.f); const float cs = cosf(ang), sn = sinf(ang);
          const float u1 = bf2f(pr[C_KR + j]), u2 = bf2f(pr[C_KR + 32 + j]); const bf16_t* kr = (const bf16_t*)(ws + WS_KR) + (size_t)row * 64;
          if (bad(bf2f(kr[j]), u1 * cs - u2 * sn, 0.02f, 0.02f) || bad(bf2f(kr[32 + j]), u1 * sn + u2 * cs, 0.02f, 0.02f)) atomicOr(flag, 1u << 6);
          const f32x2 c2 = ((const f32x2*)(ws + WS_CS))[(size_t)row * 32 + j]; if (bad(c2[0], cs, 0.f, 3e-3f) || bad(c2[1], sn, 0.f, 3e-3f)) atomicOr(flag, 1u << 6); }
        { const int c = h1 % RW; const bf16_t* pp = pr - IN_COLS; const bool hp = t > 0; float sw = 0.f, sa = 0.f, sg = 0.f;
          for (int k = 0; k < 96; ++k) { float v = bf2f(pr[C_WD + k]); const float q = hp ? bf2f(pp[C_WD + k]) : 0.f; v += (q - v) * in[I_MU][C_WD + k]; sw += bf2f(f2bf(tanhf(v))) * in[I_WDEC][(size_t)k * RW + c];
                                        float v2 = bf2f(pr[C_AD + k]); const float q2 = hp ? bf2f(pp[C_AD + k]) : 0.f; v2 += (q2 - v2) * in[I_MU][C_AD + k]; sa += bf2f(f2bf(v2)) * in[I_WICLR][(size_t)k * RW + c]; }
          for (int k = 0; k < 256; ++k) { float v = bf2f(pr[C_GD + k]); const float q = hp ? bf2f(pp[C_GD + k]) : 0.f; v += (q - v) * in[I_MU][C_GD + k]; sg += bf2f(f2bf(1.f / (1.f + expf(-v)))) * in[I_WGATE][(size_t)k * RW + c]; }
          const float z = in[I_W0][c] + sw; const float wl = -log1pf(expf(-z)) - 0.5f; const float ld = -expf(wl);
          const float* LD = a.out; const bf16_t* Ab = (const bf16_t*)((const char*)a.out + 64 * MiB); const bf16_t* Gb = (const bf16_t*)((const char*)a.out + 96 * MiB);
          if (bad(LD[(size_t)row * RW + c], ld, 0.02f, 1e-3f)) atomicOr(flag, 1u << 7);
          if (bad(bf2f(Ab[(size_t)row * RW + c]), 1.f / (1.f + expf(-(in[I_A0][c] + sa))), 0.02f, 5e-3f)) atomicOr(flag, 1u << 7);
          if (bad(bf2f(Gb[(size_t)row * RW + c]), sg, 0.03f, 0.02f)) atomicOr(flag, 1u << 7); }
        return;
    } else if (phase == 6) {
        bit = 8; const int hh = h1 % MH, d = (h1 >> 8) % DV; const bf16_t* Q = (const bf16_t*)(ws + WS_Q) + (size_t)row * QW + hh * QHD; const f32x2* cs = (const f32x2*)(ws + WS_CS) + (size_t)row * 32;
        const int nk = ((t >> 6) + 1) << 6; float mx = -1e30f, l = 0.f, o = 0.f;
        for (int pass = 0; pass < 2; ++pass)
        for (int k = 0; k < nk; ++k) { const bf16_t* kn = (const bf16_t*)(ws + WS_KV) + ((size_t)b * SEQ + k) * KVW + hh * 256; const bf16_t* kr = (const bf16_t*)(ws + WS_KR) + ((size_t)b * SEQ + k) * 64; float s = 0.f;
            for (int i = 0; i < DN; ++i) s += bf2f(Q[i]) * bf2f(kn[i]);
            for (int i = 0; i < 32; ++i) { const float u1 = bf2f(Q[DN + i]), u2 = bf2f(Q[DN + 32 + i]); s += bf2f(f2bf(u1 * cs[i][0] - u2 * cs[i][1])) * bf2f(kr[i]) + bf2f(f2bf(u1 * cs[i][1] + u2 * cs[i][0])) * bf2f(kr[32 + i]); }
            if (pass == 0) mx = fmaxf(mx, s); else { const float p = exp2f(s - mx); l += p; o += p * bf2f(kn[DN + d]); } }
        f = bad(bf2f(((const bf16_t*)(ws + WS_YCAT))[(size_t)row * DM + RW + hh * DV + d]), o / l, 0.03f, 0.01f);
    } else if (phase == 7) {
        bit = 9; const int c = h1 % DM; const bf16_t* yr = (const bf16_t*)(ws + WS_YCAT) + (size_t)row * DM; float s = 0.f;
        for (int k = 0; k < DM; ++k) s += bf2f(yr[k]) * in[I_WOUT][(size_t)k * DM + c];
        f = bad(bf2f(((const bf16_t*)(ws + WS_O1))[(size_t)row * DM + c]), s, 0.02f, 0.02f);
    } else if (phase == 8) {
        bit = 10; const int c = h1 % DM; const bf16_t* orow = (const bf16_t*)(ws + WS_O1) + (size_t)row * DM; float ss = 0.f;
        for (int k = 0; k < DM; ++k) { const float v = bf2f(orow[k]); ss += v * v; }
        const float r1 = rsqrtf(ss / DM + NORM_EPS); float s2 = 0.f; float x2c = 0.f;
        for (int k = 0; k < DM; ++k) { const float v = in[I_X][(size_t)row * DM + k] + d_modv(ws, in[I_BMOD], b, 4096 + k) * in[I_GPOSTMIX][k] * bf2f(orow[k]) * r1; s2 += v * v; if (k == c) x2c = v; }
        f = bad(a.out[(size_t)row * DM + c], x2c, 0.01f, 0.01f);
        const float h2 = x2c * rsqrtf(s2 / DM + NORM_EPS) * in[I_GPREFFN][c] * (1.f + d_modv(ws, in[I_BMOD], b, 8192 + c)) + d_modv(ws, in[I_BMOD], b, 6144 + c);
        f = f || bad(bf2f(((const bf16_t*)(ws + WS_H))[(size_t)row * DM + c]), h2, 0.02f, 0.02f);
    } else if (phase == 10) {
        bit = 11; const int cc = h1 % DFF; float ug[3] = {0.f, 0.f, 0.f}, uv[3] = {0.f, 0.f, 0.f};
        for (int d = 0; d < 3; ++d) { if (t - d < 0) continue; const bf16_t* hr = (const bf16_t*)(ws + WS_H) + (size_t)(row - d) * DM;
            for (int k = 0; k < DM; ++k) { const float hv = bf2f(hr[k]); ug[d] += hv * in[I_WUP][(size_t)k * UPW + cc]; uv[d] += hv * in[I_WUP][(size_t)k * UPW + DFF + cc]; } }
        const float* cw = in[I_CONVW]; const float* cb = in[I_CONVB];
        const float gc = cb[cc] + cw[2 * UPW + cc] * ug[0] + cw[UPW + cc] * ug[1] + cw[cc] * ug[2];
        const float vc = cb[DFF + cc] + cw[2 * UPW + DFF + cc] * uv[0] + cw[UPW + DFF + cc] * uv[1] + cw[DFF + cc] * uv[2];
        const float ge = 0.5f * gc * (1.f + tanhf(0.7978845608f * (gc + 0.044715f * gc * gc * gc)));
        f = bad(bf2f(((const bf16_t*)(ws + WS_ACT))[(size_t)row * DFF + cc]), ge * vc, 0.04f, 0.03f);
        { const int r256 = row & 255, pm = row >> 8; const int ng = 256 * (cc >> 7) + (cc & 127);
          if (r256 < 2) { const float hv = ((const float*)(ws + WS_HEAD))[((size_t)pm * 2 + r256) * UPW + ng]; if (bad(hv, ug[0], 0.02f, 0.02f)) atomicOr(flag + 1, 1u << 4);
                          const float hv2 = ((const float*)(ws + WS_HEAD))[((size_t)pm * 2 + r256) * UPW + ng + 128]; if (bad(hv2, uv[0], 0.02f, 0.02f)) atomicOr(flag + 1, 1u << 5); }
          if (r256 >= 254) { const float hv = ((const float*)(ws + WS_TAIL))[((size_t)pm * 2 + (r256 - 254)) * UPW + ng]; if (bad(hv, ug[0], 0.02f, 0.02f)) atomicOr(flag + 1, 1u << 6); } }
        if ((row & 15) >= 2 && (row & 15) <= 13 && fabsf(ge * vc) > 0.3f) {
            float up[2] = {0.f, 0.f}, vp[2] = {0.f, 0.f};
            for (int d = 1; d < 3; ++d) { const bf16_t* hr = (const bf16_t*)(ws + WS_H) + (size_t)(row + d) * DM;
                for (int k = 0; k < DM; ++k) { const float hv = bf2f(hr[k]); up[d - 1] += hv * in[I_WUP][(size_t)k * UPW + cc]; vp[d - 1] += hv * in[I_WUP][(size_t)k * UPW + DFF + cc]; } }
            const float got = bf2f(((const bf16_t*)(ws + WS_ACT))[(size_t)row * DFF + cc]);
            #define GEL(x) (0.5f * (x) * (1.f + tanhf(0.7978845608f * ((x) + 0.044715f * (x) * (x) * (x)))))
            #define MT(v) (fabsf(got - (v)) <= 0.02f + 0.04f * fabsf(v))
            atomicAdd(flag + 8, 1u);
            const bool mm = !MT(ge * vc);
            if (!mm) atomicAdd(flag + 9, 1u); else atomicAdd(flag + 19, 1u);
            if (mm) { if (atomicCAS(flag + 30, 0u, 1u) == 0u) { ((float*)flag)[31] = got; ((float*)flag)[32] = ge * vc; ((float*)flag)[33] = gc; ((float*)flag)[34] = vc; }
                   const int lc = cc & 127, r256 = row & 255; const int fe = lc & 3, fn = (lc >> 2) & 1, ffq = (lc >> 3) & 3, fwc = lc >> 5, fai = r256 >> 7, fwr = (r256 >> 6) & 1, fm = (r256 >> 4) & 3;
                   atomicOr(flag + 27, 1u << ((cc >> 7) >> 2)); atomicOr(flag + 28, 1u << ((row >> 8) & 15)); atomicOr(flag + 29, 1u << (row >> 12));
                   atomicOr(flag + 20, 1u << fe); atomicOr(flag + 21, 1u << fn); atomicOr(flag + 22, 1u << fm); atomicOr(flag + 23, 1u << fai); atomicOr(flag + 24, 1u << fwr); atomicOr(flag + 25, 1u << ffq); atomicOr(flag + 26, 1u << fwc); }
            { const float g2 = cb[cc] + cw[2 * UPW + cc] * ug[0] + cw[UPW + cc] * up[0] + cw[cc] * up[1]; const float v2 = cb[DFF + cc] + cw[2 * UPW + DFF + cc] * uv[0] + cw[UPW + DFF + cc] * vp[0] + cw[DFF + cc] * vp[1];
              if (MT(GEL(g2) * v2)) atomicAdd(flag + 10, mm ? 1u : 0u); }
            { const float g2 = cb[cc] + cw[2 * UPW + cc] * ug[0]; const float v2 = cb[DFF + cc] + cw[2 * UPW + DFF + cc] * uv[0];
              if (MT(GEL(g2) * v2)) atomicAdd(flag + 11, mm ? 1u : 0u); }
            { if (MT(GEL(vc) * gc)) atomicAdd(flag + 12, mm ? 1u : 0u); }
            { const float g2 = cb[cc] + cw[2 * UPW + cc] * ug[0] + cw[cc] * ug[1] + cw[UPW + cc] * ug[2]; const float v2 = cb[DFF + cc] + cw[2 * UPW + DFF + cc] * uv[0] + cw[DFF + cc] * uv[1] + cw[UPW + DFF + cc] * uv[2];
              if (MT(GEL(g2) * v2)) atomicAdd(flag + 13, mm ? 1u : 0u); }
            { const float g2 = cb[cc] + cw[cc] * ug[0] + cw[UPW + cc] * ug[1] + cw[2 * UPW + cc] * ug[2]; const float v2 = cb[DFF + cc] + cw[DFF + cc] * uv[0] + cw[UPW + DFF + cc] * uv[1] + cw[2 * UPW + DFF + cc] * uv[2];
              if (MT(GEL(g2) * v2)) atomicAdd(flag + 14, mm ? 1u : 0u); }
            if (MT(gc * vc)) atomicAdd(flag + 15, mm ? 1u : 0u);
            if (MT(ge)) atomicAdd(flag + 16, mm ? 1u : 0u);
            { const float g2 = cb[cc] + cw[2 * UPW + cc] * ug[0] + cw[UPW + cc] * ug[1]; const float v2 = cb[DFF + cc] + cw[2 * UPW + DFF + cc] * uv[0] + cw[UPW + DFF + cc] * uv[1];
              if (MT(GEL(g2) * v2)) atomicAdd(flag + 17, mm ? 1u : 0u); }
            { const float g2 = cb[cc] + cw[2 * UPW + cc] * ug[0] + cw[cc] * ug[2]; const float v2 = cb[DFF + cc] + cw[2 * UPW + DFF + cc] * uv[0] + cw[DFF + cc] * uv[2];
              if (MT(GEL(g2) * v2)) atomicAdd(flag + 18, mm ? 1u : 0u); }
            { const float v2 = cb[DFF + cc] + cw[2 * UPW + DFF + cc] * uv[0]; if (mm && MT(ge * v2)) atomicAdd(flag + 40, 1u); }
            { const float g2 = cb[cc] + cw[2 * UPW + cc] * ug[0]; if (mm && MT(GEL(g2) * vc)) atomicAdd(flag + 41, 1u); }
            { const float v2 = cb[DFF + cc] + cw[2 * UPW + cc] * uv[0] + cw[UPW + cc] * uv[1] + cw[cc] * uv[2]; if (mm && MT(ge * v2)) atomicAdd(flag + 42, 1u); }
            { const float g2 = cb[cc] + cw[2 * UPW + DFF + cc] * ug[0] + cw[UPW + DFF + cc] * ug[1] + cw[DFF + cc] * ug[2]; if (mm && MT(GEL(g2) * vc)) atomicAdd(flag + 43, 1u); }
            { const float g2 = gc - cb[cc], v2 = vc - cb[DFF + cc]; if (mm && MT(GEL(g2) * v2)) atomicAdd(flag + 44, 1u); }
            { const float v2 = cb[DFF + cc] + cw[2 * UPW + DFF + cc] * uv[0] + cw[UPW + DFF + cc] * uv[1]; if (mm && MT(ge * v2)) atomicAdd(flag + 45, 1u); }
            { const float v2 = cb[DFF + cc] + cw[2 * UPW + DFF + cc] * uv[0] + cw[DFF + cc] * uv[2]; if (mm && MT(ge * v2)) atomicAdd(flag + 46, 1u); }
            { const float v2 = cb[DFF + cc] + cw[UPW + DFF + cc] * uv[1] + cw[DFF + cc] * uv[2]; if (mm && MT(ge * v2)) atomicAdd(flag + 47, 1u); }
            { if (mm && MT(ge * uv[0])) atomicAdd(flag + 48, 1u); }
            { if (mm && MT(GEL(ug[0]) * vc)) atomicAdd(flag + 49, 1u); }
        }
        if (f) { const int r256 = row & 255; const int cls = (r256 < 2) ? 0 : ((row & 63) < 2) ? 1 : ((row & 15) < 2) ? 2 : 3; atomicOr(flag + 1, 1u << cls); }
    } else if (phase == 11) {
        bit = 12; const int c = h1 % DM; const bf16_t* ar = (const bf16_t*)(ws + WS_ACT) + (size_t)row * DFF; float s = 0.f;
        for (int k = 0; k < DFF; ++k) s += bf2f(ar[k]) * in[I_WDOWN][(size_t)k * DM + c];
        f = bad(bf2f(((const bf16_t*)(ws + WS_O2))[(size_t)row * DM + c]), s, 0.02f, 0.02f);
    } else return;
    if (f) atomicOr(flag, 1u << bit);
}
__global__ void chk_apply(Args a) {
    const unsigned* fl = (const unsigned*)(a.ws + WS_CTL) + 8;
    if (blockIdx.x == 0 && threadIdx.x == 0) {
        const unsigned n = fl[8]; unsigned best = 0, bi = 0;
        for (unsigned i = 1; i <= 9; ++i) if (fl[9 + i] > best) { best = fl[9 + i]; bi = i; }
        const unsigned mainf = n ? (fl[9] * 9u + n / 2) / n : 0u, bestf = n ? (best * 9u + n / 2) / n : 0u;
        const unsigned mk = fl[27]; unsigned pc = __popc(mk); if (pc > 9u) pc = 9u; unsigned lo = mk ? (unsigned)(__ffs(mk) - 1) : 0u; if (lo > 9u) lo = 9u;
        (void)pc; (void)lo; const float* ff = (const float*)fl;
        const unsigned nm = fl[19]; unsigned best2 = 0, bi2 = 0; const int base = MK_RPT ? 40 : 10;
        for (unsigned i = 0; i < (MK_RPT ? 10u : 9u); ++i) if (fl[base + i] > best2) { best2 = fl[base + i]; bi2 = i; }
        unsigned code = 10u * bi2 + (nm ? (best2 * 9u + nm / 2) / nm : 0u); (void)ff;
        a.out[0] = 1000.f * (float)code;
        a.out[1] = -100.f * (float)(1u + bestf);
    }
}
#endif
extern "C" void kernel_launch(void* const* d_in, const int* in_sizes, int n_in, void* d_out, int out_size, void* d_ws, size_t ws_size, hipStream_t stream) {
    static int grid = 0;
    if (grid == 0) {
        if (n_in != 30 || in_sizes[0] != TOK * DM || out_size != TOK * DM || ws_size < WS_END) {
            fprintf(stderr, "kernel_launch: unexpected shapes: n_in %d in0 %d out %d ws %zu (need %zu)\n", n_in, n_in > 0 ? in_sizes[0] : -1, out_size, ws_size, (size_t)WS_END); grid = -1; return; }
        int dev = 0, cus = 0, per_cu = 0;
        if (hipGetDevice(&dev) != hipSuccess || hipDeviceGetAttribute(&cus, hipDeviceAttributeMultiprocessorCount, dev) != hipSuccess) { fprintf(stderr, "kernel_launch: device query failed\n"); grid = -1; return; }
        if (hipFuncSetAttribute((const void*)mk_fwd, hipFuncAttributeMaxDynamicSharedMemorySize, LDS_BYTES) != hipSuccess) { fprintf(stderr, "kernel_launch: hipFuncSetAttribute failed\n"); grid = -1; return; }
        if (hipOccupancyMaxActiveBlocksPerMultiprocessor(&per_cu, (const void*)mk_fwd, NWAVES * 64, LDS_BYTES) != hipSuccess || per_cu < 1) {
            fprintf(stderr, "kernel_launch: occupancy query reports %d blocks per CU\n", per_cu); grid = -1; (void)hipGetLastError(); return; }
        (void)hipGetLastError();
        grid = cus;
    }
    if (grid < 0) return;
    if (hipMemsetAsync((char*)d_ws + WS_CTL, 0, CTL_ZERO_BYTES, stream) != hipSuccess) { fprintf(stderr, "kernel_launch: memset failed\n"); return; }
    Args a{};
    for (int i = 0; i < 30; ++i) a.in[i] = d_in[i];
    a.out = (float*)d_out; a.ws = (unsigned char*)d_ws;
#if MK_ONE_LAUNCH
    a.ph_lo = 0; a.ph_hi = N_PHASES; a.li = 0;
    hipLaunchKernelGGL(mk_fwd, dim3(grid), dim3(NWAVES * 64), LDS_BYTES, stream, a);
#else
    for (int p = 0; p < N_PHASES; ++p) { a.ph_lo = p; a.ph_hi = p + 1; a.li = 0; hipLaunchKernelGGL(mk_fwd, dim3(grid), dim3(NWAVES * 64), LDS_BYTES, stream, a);
#if MK_CHECK
        hipLaunchKernelGGL(chk, dim3(1), dim3(512), 0, stream, p, a);
#endif
    }
#if MK_CHECK
    hipLaunchKernelGGL(chk_apply, dim3(1024), dim3(256), 0, stream, a);
#endif
#endif
    const hipError_t le = hipPeekAtLastError();
    if (le != hipSuccess) fprintf(stderr, "kernel_launch: launch failed: %s\n", hipGetErrorName(le));
}
```

```cpp
#include <hip/hip_runtime.h>
#include <cstdio>
#include <cstdint>

#ifndef MK_CHECK
#define MK_CHECK 0
#endif
#ifndef MK_RPT
#define MK_RPT 0
#endif
#ifndef MK_NODELTA
#define MK_NODELTA 0
#endif
#ifndef MK_ONE_LAUNCH
#define MK_ONE_LAUNCH 1
#endif

constexpr int DM = 2048, NB = 4, SEQ = 4096, TOK = NB * SEQ;
constexpr int RW = 1024, RH = 16, RN = 64;
constexpr int IN_COLS = 4352;
constexpr int C_R = 0, C_K = 1024, C_V = 2048, C_WD = 3072, C_AD = 3168, C_GD = 3264, C_QL = 3520, C_KVL = 4032, C_KR = 4288;
constexpr int QLR = 512, KVLR = 256, MH = 8, DN = 128, DR = 64, DV = 128, QHD = 192;
constexpr int QW = MH * QHD, KVW = MH * (DN + DV);
constexpr int DFF = 5632, UPW = 2 * DFF;
constexpr float NORM_EPS = 1e-6f, GN_EPS = 64e-5f;
constexpr int LAW = 512;

constexpr size_t MiB = 1u << 20;
constexpr size_t WS_CTL = 0, CTL_ZERO_BYTES = 64 * 1024;
constexpr size_t WS_MODP = 1 * MiB;
constexpr size_t WS_RSTDQ = 1 * MiB + 800 * 1024;
constexpr size_t WS_RSTDKV = WS_RSTDQ + 64 * 1024;
constexpr size_t WS_SSQ1 = 2 * MiB, WS_SSQ2 = 4 * MiB;
constexpr size_t WS_HEAD = 6 * MiB, WS_TAIL = 12 * MiB;
constexpr size_t WS_WIN = 18 * MiB, WS_WQ = 35 * MiB, WS_WKV = 37 * MiB, WS_WOUT = 38 * MiB, WS_WUP = 46 * MiB, WS_WDOWN = 90 * MiB;
constexpr size_t WS_WDEC = 112 * MiB, WS_WICLR = WS_WDEC + 256 * 1024, WS_WGATE = WS_WICLR + 256 * 1024;
constexpr size_t WS_CONV = WS_WGATE + 512 * 1024;
constexpr size_t WS_H = 114 * MiB;
constexpr size_t WS_LA = WS_H;
constexpr size_t WS_P = 178 * MiB;
constexpr size_t WS_Q = 314 * MiB;
constexpr size_t WS_KV = 362 * MiB;
constexpr size_t WS_KR = 426 * MiB;
constexpr size_t WS_CS = 428 * MiB;
constexpr size_t WS_YCAT = 432 * MiB;
constexpr size_t WS_END = 496 * MiB;
constexpr size_t WS_O1 = WS_Q;
constexpr size_t WS_ACT = WS_P;
constexpr size_t WS_O2 = WS_YCAT;
static_assert(WS_ACT + (size_t)TOK * DFF * 2 <= WS_KV + 64 * MiB, "act overlay");

#define GAS __attribute__((address_space(1)))
#define LAS __attribute__((address_space(3)))
typedef unsigned short bf16_t;
typedef short bf16x8 __attribute__((ext_vector_type(8)));
typedef float f32x4 __attribute__((ext_vector_type(4)));
typedef float f32x2 __attribute__((ext_vector_type(2)));
typedef float f32x16 __attribute__((ext_vector_type(16)));
typedef unsigned u32x4 __attribute__((ext_vector_type(4)));
typedef unsigned u32x2 __attribute__((ext_vector_type(2)));
typedef short s16x4 __attribute__((ext_vector_type(4)));
typedef GAS unsigned gu32;

typedef __bf16 bf16x2_t __attribute__((ext_vector_type(2)));
__device__ __forceinline__ unsigned cvt_pk_bf16(float lo, float hi) { const f32x2 v = {lo, hi}; const bf16x2_t b = __builtin_convertvector(v, bf16x2_t); return __builtin_bit_cast(unsigned, b); }
__device__ __forceinline__ unsigned cvt_pk_bf16_asm(float lo, float hi) { unsigned r; asm volatile("v_cvt_pk_bf16_f32 %0, %1, %2" : "=v"(r) : "v"(lo), "v"(hi)); return r; }
__device__ __forceinline__ float bf2f(unsigned short u) { return __uint_as_float((unsigned)u << 16); }
__device__ __forceinline__ float bflo(unsigned w) { return __uint_as_float(w << 16); }
__device__ __forceinline__ float bfhi(unsigned w) { return __uint_as_float(w & 0xffff0000u); }
__device__ __forceinline__ unsigned short f2bf(float f) { return (unsigned short)(cvt_pk_bf16(f, f) & 0xffffu); }
__device__ __forceinline__ float wave_sum(float v) {
#pragma unroll
    for (int o = 1; o < 64; o <<= 1) v += __shfl_xor(v, o);
    return v;
}
__device__ __forceinline__ float fast_exp(float x) { return __builtin_amdgcn_exp2f(x * 1.4426950408889634f); }
__device__ __forceinline__ float fast_sigmoid(float x) { return __builtin_amdgcn_rcpf(1.f + fast_exp(-x)); }
__device__ __forceinline__ float fast_tanh(float x) { return 1.f - 2.f * __builtin_amdgcn_rcpf(1.f + fast_exp(2.f * x)); }
namespace pg8 {
constexpr int BM = 256, BK = 64, HALF = 128, HTB = HALF * BK * 2, STAGE_BYTES = 8 * HTB, NXCD = 8, WGM = 8;
__host__ __device__ __forceinline__ int lds_byte(int r, int c) { const int st = (r >> 4) * 2 + (c >> 5), rr = r & 15, cc = c & 31, ob = rr * 64 + cc * 2; return st * 1024 + (ob ^ (((ob >> 9) & 1) << 5)); }
__host__ __device__ __forceinline__ void stage_rc(int b, int& R, int& C) { const int st = b / 1024, sb = b % 1024, swz = sb ^ (((sb >> 9) & 1) << 5); R = (st >> 1) * 16 + swz / 64; C = (st & 1) * 32 + (swz % 64) / 2; }
__host__ __device__ __forceinline__ int perm32(int rho) { const int n = rho >> 4, i = rho & 15; return 8 * (i >> 2) + 4 * n + (i & 3); }

struct Unit { int pm, pn; };
struct Gemm { const bf16_t* A; const bf16_t* Bt; int M, N, K, lda, ldb; };

struct StaticOrder {
    int nM, nN, nwg, G, c, flip = 0;
    __host__ __device__ void init(int M, int N, int G_, int c_) { nM = M / BM; nN = N / BM; nwg = nM * nN; G = G_; c = c_; }
    __host__ __device__ bool next(int i, Unit& u) const {
        const long L = (long)i * G + c; if (L >= nwg) return false;
        int wgid = (int)L; { const int q = nwg / NXCD, r = nwg % NXCD, xcd = wgid % NXCD, off = wgid / NXCD; wgid = (xcd < r ? xcd * (q + 1) : r * (q + 1) + (xcd - r) * q) + off; }
        const int nig = WGM * nN, gid = wgid / nig, fm = gid * WGM, gsz = (nM - fm) < WGM ? (nM - fm) : WGM;
        u.pm = fm + ((wgid % nig) % gsz); u.pn = (wgid % nig) / gsz; if (flip) u.pn = nN - 1 - u.pn; return true;
    }
};


template <class Epi, class Sched>
__device__ __forceinline__ void gemm_phase(LAS unsigned char* lds, const Gemm g, const Sched& S, const Epi& E) {
    const int tid = threadIdx.x, wid = __builtin_amdgcn_readfirstlane(tid >> 6), lane = tid & 63, wr = wid >> 2, wc = wid & 3, fr = lane & 15, fq = lane >> 4;
    const int K = g.K, nt = K / BK;
    unsigned voffA[2], voffB[2];
#pragma unroll
    for (int i = 0; i < 2; ++i) { int R, C; stage_rc(tid * 16 + i * 8192, R, C); const int Rb = (R & ~31) + perm32(R & 31);
        voffA[i] = (unsigned)(R * g.lda + C) * 2u; voffB[i] = (unsigned)(Rb * g.ldb + C) * 2u; }
    const size_t kstep = (size_t)(BK * 2);
    const size_t hstepA = (size_t)HALF * g.lda * 2, hstepB = (size_t)HALF * g.ldb * 2;
    const size_t tstepA = 2 * hstepA, tstepB = 2 * hstepB;
    const unsigned ldsw = (unsigned)wid * 1024u;
    const int aoff = lds_byte(wr * 64 + fr, fq * 8), boff = lds_byte(wc * 32 + fr, fq * 8);
#define PG8_SA(b, h) (((b) * 2 + (h)) * HTB)
#define PG8_SB(b, h) ((4 + (b) * 2 + (h)) * HTB)
#define PG8_STAGE(bufoff, gbase, voff) do { _Pragma("unroll") for (int _i = 0; _i < 2; ++_i) \
        __builtin_amdgcn_global_load_lds((const unsigned*)((const char*)(gbase) + (voff)[_i]), (LAS unsigned*)(lds + (bufoff) + ldsw + _i * 8192), 16, 0, 0); } while (0)
#define PG8_LDA(dst, b, h) do { _Pragma("unroll") for (int m = 0; m < 4; ++m) _Pragma("unroll") for (int k = 0; k < 2; ++k) dst[m][k] = *(const LAS bf16x8*)(lds + PG8_SA(b, h) + aoff + m * 2048 + k * 1024); } while (0)
#define PG8_LDB(dst, b, h) do { _Pragma("unroll") for (int n = 0; n < 2; ++n) _Pragma("unroll") for (int k = 0; k < 2; ++k) dst[n][k] = *(const LAS bf16x8*)(lds + PG8_SB(b, h) + boff + n * 2048 + k * 1024); } while (0)
#define PG8_MMA(ai, bj, At, Bt) do { __builtin_amdgcn_s_setprio(1); _Pragma("unroll") for (int m = 0; m < 4; ++m) _Pragma("unroll") for (int n = 0; n < 2; ++n) _Pragma("unroll") for (int k = 0; k < 2; ++k) \
        acc[ai][bj][m][n] = __builtin_amdgcn_mfma_f32_16x16x32_bf16(Bt[n][k], At[m][k], acc[ai][bj][m][n], 0, 0, 0); __builtin_amdgcn_s_setprio(0); } while (0)
#define PG8_WAIT_V(n) asm volatile("s_waitcnt vmcnt(" #n ")" ::: "memory")
#define PG8_WAIT_L(n) asm volatile("s_waitcnt lgkmcnt(" #n ")" ::: "memory")
#define PG8_BAR __builtin_amdgcn_s_barrier()
#define PG8_SCHED __builtin_amdgcn_sched_barrier(0)
    Unit cur, nxt; int ui = 0;
    if (!S.next(0, cur)) return;
    f32x4 acc[2][2][4][2];
#pragma unroll
    for (int a = 0; a < 2; ++a)
#pragma unroll
        for (int b = 0; b < 2; ++b)
#pragma unroll
            for (int m = 0; m < 4; ++m)
#pragma unroll
                for (int n = 0; n < 2; ++n) acc[a][b][m][n] = (f32x4){0.f, 0.f, 0.f, 0.f};
    bf16x8 At[4][2], B0[2][2], B1[2][2];
    const char* cA = (const char*)g.A + (size_t)cur.pm * tstepA; const char* cB = (const char*)g.Bt + (size_t)cur.pn * tstepB;
    PG8_STAGE(PG8_SB(0, 0), cB, voffB); PG8_STAGE(PG8_SB(0, 1), cB + hstepB, voffB); PG8_STAGE(PG8_SA(0, 0), cA, voffA); PG8_STAGE(PG8_SA(0, 1), cA + hstepA, voffA);
    if (wr == 1) PG8_BAR;
    PG8_WAIT_V(2); PG8_BAR;
    PG8_STAGE(PG8_SB(1, 0), cB + kstep, voffB); PG8_STAGE(PG8_SA(1, 0), cA + kstep, voffA); PG8_STAGE(PG8_SB(1, 1), cB + hstepB + kstep, voffB);
    PG8_WAIT_V(6); PG8_BAR;
    for (;;) {
        const bool has_next = S.next(ui + 1, nxt);
        const char* nA = has_next ? (const char*)g.A + (size_t)nxt.pm * tstepA : cA; const char* nB = has_next ? (const char*)g.Bt + (size_t)nxt.pn * tstepB : cB;
        for (int t = 0; t < nt; t += 2) {
            const bool last = (t == nt - 2);
            const char* a1 = cA + (size_t)(t + 1) * kstep;
            const char* a2 = last ? nA : cA + (size_t)(t + 2) * kstep; const char* b2 = last ? nB : cB + (size_t)(t + 2) * kstep;
            const char* a3 = a2 + kstep; const char* b3 = b2 + kstep;
            PG8_LDB(B0, 0, 0); PG8_LDB(B1, 0, 1); PG8_SCHED; PG8_LDA(At, 0, 0); PG8_STAGE(PG8_SA(1, 1), a1 + hstepA, voffA);
            PG8_WAIT_V(8); PG8_WAIT_L(0); PG8_BAR; PG8_MMA(0, 0, At, B0); PG8_MMA(0, 1, At, B1); PG8_BAR; PG8_SCHED;
            PG8_LDA(At, 0, 1); PG8_STAGE(PG8_SB(0, 0), b2, voffB); PG8_STAGE(PG8_SB(0, 1), b2 + hstepB, voffB); PG8_STAGE(PG8_SA(0, 0), a2, voffA);
            PG8_WAIT_V(8); PG8_WAIT_L(0); PG8_BAR; PG8_MMA(1, 0, At, B0); PG8_MMA(1, 1, At, B1); PG8_BAR; PG8_SCHED;
            PG8_LDB(B0, 1, 0); PG8_LDB(B1, 1, 1); PG8_SCHED; PG8_LDA(At, 1, 0); PG8_STAGE(PG8_SA(0, 1), a2 + hstepA, voffA);
            PG8_WAIT_V(8); PG8_WAIT_L(0); PG8_BAR; PG8_MMA(0, 0, At, B0); PG8_MMA(0, 1, At, B1); PG8_BAR; PG8_SCHED;
            PG8_LDA(At, 1, 1); PG8_STAGE(PG8_SB(1, 0), b3, voffB); PG8_STAGE(PG8_SB(1, 1), b3 + hstepB, voffB); PG8_STAGE(PG8_SA(1, 0), a3, voffA);
            PG8_WAIT_V(8); PG8_WAIT_L(0); PG8_BAR; PG8_MMA(1, 0, At, B0); PG8_MMA(1, 1, At, B1); PG8_BAR; PG8_SCHED;
        }
        if (wr == 0) PG8_BAR;
        E(acc, cur, wr, wc, fr, fq);
        if (!has_next) break;
#pragma unroll
        for (int a = 0; a < 2; ++a)
#pragma unroll
            for (int b = 0; b < 2; ++b)
#pragma unroll
                for (int m = 0; m < 4; ++m)
#pragma unroll
                    for (int n = 0; n < 2; ++n) acc[a][b][m][n] = (f32x4){0.f, 0.f, 0.f, 0.f};
        cur = nxt; cA = nA; cB = nB; ++ui;
        if (wr == 1) PG8_BAR;
    }
    PG8_WAIT_V(0);
    PG8_BAR;
#undef PG8_SA
#undef PG8_SB
#undef PG8_STAGE
#undef PG8_LDA
#undef PG8_LDB
#undef PG8_MMA
#undef PG8_WAIT_V
#undef PG8_WAIT_L
#undef PG8_BAR
#undef PG8_SCHED
}
}
template <int MODE> struct EpiOut {
    static constexpr bool SYNC = false;
    bf16_t* O; float* Of; int ldc; const float* rowscale; float s; const float* bias; float* ssq;
    __device__ __forceinline__ void operator()(f32x4 (&acc)[2][2][4][2], const pg8::Unit& u, int wr, int wc, int fr, int fq) const {
        const int row0 = u.pm * 256 + wr * 64 + fr, col0 = u.pn * 256 + wc * 32 + 8 * fq;
        f32x4 bv[2][2];
        if (MODE == 2 || MODE == 3) {
#pragma unroll
            for (int bj = 0; bj < 2; ++bj)
#pragma unroll
                for (int n = 0; n < 2; ++n) bv[bj][n] = *(const f32x4*)(bias + col0 + bj * 128 + 4 * n);
        }
#pragma unroll
        for (int ai = 0; ai < 2; ++ai)
#pragma unroll
            for (int m = 0; m < 4; ++m) {
                const int row = row0 + ai * 128 + m * 16;
                float rs = 1.f; if (MODE == 1) rs = rowscale[row] * s;
                float q = 0.f;
#pragma unroll
                for (int bj = 0; bj < 2; ++bj) {
                    f32x4 v0 = acc[ai][bj][m][0], v1 = acc[ai][bj][m][1];
                    if (MODE == 1) { v0 = v0 * rs; v1 = v1 * rs; }
                    if (MODE == 2) {
                        v0 = v0 + bv[bj][0]; v1 = v1 + bv[bj][1];
#pragma unroll
                        for (int e = 0; e < 4; ++e) {
                            { const float y = -v0[e]; const float sp = fmaxf(y, 0.f) + __logf(1.f + __expf(-fabsf(y))); v0[e] = -__expf(-sp - 0.5f); }
                            { const float y = -v1[e]; const float sp = fmaxf(y, 0.f) + __logf(1.f + __expf(-fabsf(y))); v1[e] = -__expf(-sp - 0.5f); }
                        }
                        float* op = Of + (size_t)row * ldc + col0 + bj * 128;
                        *(f32x4*)op = v0; *(f32x4*)(op + 4) = v1;
                        continue;
                    }
                    if (MODE == 3) {
                        v0 = v0 + bv[bj][0]; v1 = v1 + bv[bj][1];
#pragma unroll
                        for (int e = 0; e < 4; ++e) { v0[e] = fast_sigmoid(v0[e]); v1[e] = fast_sigmoid(v1[e]); }
                    }
                    if (MODE == 4) { q += (v0[0] * v0[0] + v0[1] * v0[1]) + (v0[2] * v0[2] + v0[3] * v0[3]) + (v1[0] * v1[0] + v1[1] * v1[1]) + (v1[2] * v1[2] + v1[3] * v1[3]); }
                    u32x4 w; w.x = cvt_pk_bf16(v0[0], v0[1]); w.y = cvt_pk_bf16(v0[2], v0[3]); w.z = cvt_pk_bf16(v1[0], v1[1]); w.w = cvt_pk_bf16(v1[2], v1[3]);
                    *(u32x4*)(O + (size_t)row * ldc + col0 + bj * 128) = w;
                }
                if (MODE == 4) { q += __shfl_xor(q, 16); q += __shfl_xor(q, 32); if (fq == 0) ssq[(size_t)row * 32 + u.pn * 4 + wc] = q; }
            }
    }
};

struct EpiMulti {
    static constexpr bool SYNC = false;
    int mode; bf16_t* O; float* Of; int ldc; const float* rowscale; float s; const float* bias;
    __device__ __forceinline__ void operator()(f32x4 (&acc)[2][2][4][2], const pg8::Unit& u, int wr, int wc, int fr, int fq) const {
        const int row0 = u.pm * 256 + wr * 64 + fr, col0 = u.pn * 256 + wc * 32 + 8 * fq;
#pragma unroll 1
        for (int ai = 0; ai < 2; ++ai)
#pragma unroll
            for (int m = 0; m < 4; ++m) {
                const int row = row0 + ai * 128 + m * 16;
                const float rs = (mode == 1) ? rowscale[row] * s : 1.f;
#pragma unroll
                for (int bj = 0; bj < 2; ++bj) {
                    f32x4 v0 = ai ? acc[1][bj][m][0] : acc[0][bj][m][0], v1 = ai ? acc[1][bj][m][1] : acc[0][bj][m][1];
                    v0 = v0 * rs; v1 = v1 * rs;
                    if (mode >= 2) { v0 = v0 + *(const f32x4*)(bias + col0 + bj * 128); v1 = v1 + *(const f32x4*)(bias + col0 + bj * 128 + 4); }
                    if (mode == 2) {
#pragma unroll
                        for (int e = 0; e < 4; ++e) {
                            { const float y = -v0[e]; const float sp = fmaxf(y, 0.f) + __logf(1.f + __expf(-fabsf(y))); v0[e] = -__expf(-sp - 0.5f); }
                            { const float y = -v1[e]; const float sp = fmaxf(y, 0.f) + __logf(1.f + __expf(-fabsf(y))); v1[e] = -__expf(-sp - 0.5f); }
                        }
                        float* op = Of + (size_t)row * ldc + col0 + bj * 128;
                        *(f32x4*)op = v0; *(f32x4*)(op + 4) = v1;
                    } else {
                        if (mode == 3) {
#pragma unroll
                            for (int e = 0; e < 4; ++e) { v0[e] = fast_sigmoid(v0[e]); v1[e] = fast_sigmoid(v1[e]); }
                        }
                        u32x4 w; w.x = cvt_pk_bf16(v0[0], v0[1]); w.y = cvt_pk_bf16(v0[2], v0[3]); w.z = cvt_pk_bf16(v1[0], v1[1]); w.w = cvt_pk_bf16(v1[2], v1[3]);
                        *(u32x4*)(O + (size_t)row * ldc + col0 + bj * 128) = w;
                    }
                }
            }
    }
};

__device__ __forceinline__ float gelu_tanh(float x) {
    const float uu = x * (1.f + 0.044715f * x * x);
    return x * __builtin_amdgcn_rcpf(1.f + __builtin_amdgcn_exp2f(-2.f * 0.7978845608f * 1.4426950408889634f * uu));
}
__device__ __forceinline__ float dpp_ror1(float x) { return __int_as_float(__builtin_amdgcn_update_dpp(0, __float_as_int(x), 0x121, 0xf, 0xf, false)); }
__device__ __forceinline__ float dpp_ror2(float x) { return __int_as_float(__builtin_amdgcn_update_dpp(0, __float_as_int(x), 0x122, 0xf, 0xf, false)); }

struct EpiConv {
    static constexpr bool SYNC = true;
    bf16_t* ACT; const float* cw; const float* cb; float* HEADB; float* TAILB; LAS float* TB;
    __device__ __forceinline__ void operator()(f32x4 (&acc)[2][2][4][2], const pg8::Unit& u, int wr, int wc, int fr, int fq) const {
        const int lc0 = 32 * wc + 8 * fq;
        if (fr >= 14) {
            const int rs = fr - 14;
#pragma unroll
            for (int ai = 0; ai < 2; ++ai)
#pragma unroll
                for (int bj = 0; bj < 2; ++bj)
#pragma unroll
                    for (int n = 0; n < 2; ++n) *(LAS f32x4*)(TB + ((ai * 2 + wr) * 2 + rs) * 256 + bj * 128 + lc0 + 4 * n) = acc[ai][bj][3][n];
            if (wr == 1) {
#pragma unroll
                for (int bj = 0; bj < 2; ++bj)
#pragma unroll
                    for (int n = 0; n < 2; ++n) *(f32x4*)(TAILB + ((size_t)u.pm * 2 + rs) * UPW + u.pn * 256 + bj * 128 + lc0 + 4 * n) = acc[1][bj][3][n];
            }
        }
        if (wr == 0 && fr < 2) {
#pragma unroll
            for (int bj = 0; bj < 2; ++bj)
#pragma unroll
                for (int n = 0; n < 2; ++n) *(f32x4*)(HEADB + ((size_t)u.pm * 2 + fr) * UPW + u.pn * 256 + bj * 128 + lc0 + 4 * n) = acc[0][bj][0][n];
        }
        asm volatile("s_waitcnt lgkmcnt(0)" ::: "memory"); __builtin_amdgcn_s_barrier(); asm volatile("" ::: "memory");
        u32x2 pk0[2][4];
#pragma unroll
        for (int n = 0; n < 2; ++n) {
            const int ch = u.pn * 128 + lc0 + 4 * n;
            const f32x4 w0g = *(const f32x4*)(cw + ch), w1g = *(const f32x4*)(cw + UPW + ch), w2g = *(const f32x4*)(cw + 2 * UPW + ch), bg = *(const f32x4*)(cb + ch);
            const f32x4 w0v = *(const f32x4*)(cw + DFF + ch), w1v = *(const f32x4*)(cw + UPW + DFF + ch), w2v = *(const f32x4*)(cw + 2 * UPW + DFF + ch), bvv = *(const f32x4*)(cb + DFF + ch);
#pragma unroll
            for (int ai = 0; ai < 2; ++ai) {
                f32x4 tA[2], tB[2];
                const bool haspred = (wr == 1) || (ai == 1);
                const int pa = (wr == 1) ? ai : 0, pw = (wr == 1) ? 0 : 1;
#pragma unroll
                for (int bj = 0; bj < 2; ++bj) {
                    if (haspred) { tA[bj] = *(const LAS f32x4*)(TB + ((pa * 2 + pw) * 2 + 1) * 256 + bj * 128 + lc0 + 4 * n);
                                   tB[bj] = *(const LAS f32x4*)(TB + ((pa * 2 + pw) * 2 + (fr & 1)) * 256 + bj * 128 + lc0 + 4 * n); }
                    else { tA[bj] = (f32x4){0.f, 0.f, 0.f, 0.f}; tB[bj] = (f32x4){0.f, 0.f, 0.f, 0.f}; }
                }
#pragma unroll
                for (int m = 0; m < 4; ++m) {
                    f32x4 gc, vc;
#pragma unroll
                    for (int e = 0; e < 4; ++e) {
                        const float ug = acc[ai][0][m][n][e], uv = acc[ai][1][m][n][e];
                        float cg1 = dpp_ror1(ug), cg2 = dpp_ror2(ug), cv1 = dpp_ror1(uv), cv2 = dpp_ror2(uv);
                        float qg1 = tA[0][e], qg2 = tB[0][e], qv1 = tA[1][e], qv2 = tB[1][e];
                        if (m > 0) { qg1 = dpp_ror1(acc[ai][0][m > 0 ? m - 1 : 0][n][e]); qg2 = dpp_ror2(acc[ai][0][m > 0 ? m - 1 : 0][n][e]);
                                     qv1 = dpp_ror1(acc[ai][1][m > 0 ? m - 1 : 0][n][e]); qv2 = dpp_ror2(acc[ai][1][m > 0 ? m - 1 : 0][n][e]); }
                        asm volatile("" : "+v"(cg1), "+v"(cg2), "+v"(cv1), "+v"(cv2), "+v"(qg1), "+v"(qg2), "+v"(qv1), "+v"(qv2));
                        const float pg1 = (fr == 0) ? qg1 : cg1, pg2 = (fr < 2) ? qg2 : cg2;
                        const float pv1 = (fr == 0) ? qv1 : cv1, pv2 = (fr < 2) ? qv2 : cv2;
                        gc[e] = fmaf(w0g[e], pg2, fmaf(w1g[e], pg1, fmaf(w2g[e], ug, bg[e])));
                        vc[e] = fmaf(w0v[e], pv2, fmaf(w1v[e], pv1, fmaf(w2v[e], uv, bvv[e])));
                    }
                    u32x2 pk; pk.x = cvt_pk_bf16_asm(gelu_tanh(gc[0]) * vc[0], gelu_tanh(gc[1]) * vc[1]); pk.y = cvt_pk_bf16_asm(gelu_tanh(gc[2]) * vc[2], gelu_tanh(gc[3]) * vc[3]);
                    if (n == 0) pk0[ai][m] = pk;
                    else { const int row = u.pm * 256 + ai * 128 + wr * 64 + m * 16 + fr; u32x4 w; w.x = pk0[ai][m].x; w.y = pk0[ai][m].y; w.z = pk.x; w.w = pk.y;
                           *(u32x4*)(ACT + (size_t)row * DFF + u.pn * 128 + lc0) = w; }
                }
            }
        }
    }
};
constexpr int NWAVES = 8;
constexpr int RING_OFF = 0, RING_BYTES = 131072;
constexpr int TB_OFF = RING_BYTES;
constexpr int LDSCTL_OFF = RING_BYTES + 8192, MISC_OFF = LDSCTL_OFF + 320;
constexpr int LDS_BYTES = 147456;
constexpr int CW_BAR = 4096;
#define RLX_AGENT __ATOMIC_RELAXED, __HIP_MEMORY_SCOPE_AGENT
#define LDS_WAIT() asm volatile("s_waitcnt lgkmcnt(0)" ::: "memory")
#define VM_WAIT() asm volatile("s_waitcnt vmcnt(0)" ::: "memory")

#define XB_TMO      128
#define XB_XCNT(j)  (256  + 64 * (j))
#define XB_XSUB(j)  (1280 + 64 * (j))
#define XB_XGEN(j)  (2304 + 64 * (j))
#define XB_TOP      3328
#define XB_TOPGEN   3392
#define XCD_BAR_WORDS 3456
#define XB_SPIN_CAP (1u << 20)
__device__ __forceinline__ unsigned xb_ld(unsigned* p)              { return __hip_atomic_load(p, __ATOMIC_RELAXED, __HIP_MEMORY_SCOPE_AGENT); }
__device__ __forceinline__ unsigned xb_add(unsigned* p, unsigned v) { return __hip_atomic_fetch_add(p, v, __ATOMIC_RELAXED, __HIP_MEMORY_SCOPE_AGENT); }
__device__ __forceinline__ unsigned xb_xcc_id() { return (unsigned)__builtin_amdgcn_s_getreg((3 << 11) | 20) & 0xFu; }
#define XB_SPIN(cond, bar) do { unsigned _sp = 0; while (cond) { __builtin_amdgcn_s_sleep(1); \
    if ((++_sp & 255u) == 0u) { if (xb_ld(&(bar)[XB_TMO])) break; if (_sp > XB_SPIN_CAP) { atomicAdd(&(bar)[XB_TMO], 1u); break; } } } } while (0)
struct XcdBarrier { unsigned* bar; unsigned x; volatile LAS unsigned* st; };
__device__ __forceinline__ XcdBarrier xcd_barrier_post(unsigned* bar, volatile LAS unsigned* st) {
    XcdBarrier b; b.bar = bar; b.x = xb_xcc_id(); b.st = st;
    if (threadIdx.x == 0) (void)xb_add(&bar[XB_XCNT(b.x)], 1u);
    return b;
}
__device__ __forceinline__ void xcd_barrier_complete(unsigned* bar, unsigned x, unsigned& nloc, unsigned& nx) {
    const unsigned G = gridDim.x * gridDim.y * gridDim.z;
    unsigned sum, cnt, mine, sp = 0u;
    for (;;) {
        sum = 0u; cnt = 0u; mine = 0u;
#pragma unroll
        for (unsigned j = 0; j < 16; ++j) { const unsigned c = xb_ld(&bar[XB_XCNT(j)]); sum += c; cnt += (c > 0u) ? 1u : 0u; mine = (j == x) ? c : mine; }
        if (sum == G) break;
        __builtin_amdgcn_s_sleep(1);
        if ((++sp & 255u) == 0u) { if (xb_ld(&bar[XB_TMO])) break; if (sp > XB_SPIN_CAP) { atomicAdd(&bar[XB_TMO], 1u); break; } }
    }
    nloc = mine > 0u ? mine : 1u; nx = cnt > 0u ? cnt : 1u;
}
__device__ __forceinline__ void xcd_barrier(const XcdBarrier& b) {
    asm volatile("s_waitcnt vmcnt(0)" ::: "memory");
    __syncthreads();
    if (threadIdx.x == 0) {
        unsigned* bar = b.bar;
        __builtin_amdgcn_s_waitcnt(0);
        unsigned nloc = b.st[0], nx = b.st[1];
        if (nloc == 0u) { xcd_barrier_complete(bar, b.x, nloc, nx); b.st[0] = nloc; b.st[1] = nx; }
        const unsigned old = xb_add(&bar[XB_XSUB(b.x)], 1u);
        const unsigned gen = old / nloc;
        if (old + 1u == (gen + 1u) * nloc) {
            __builtin_amdgcn_fence(__ATOMIC_RELEASE, "agent");
            asm volatile("s_waitcnt vmcnt(0)" ::: "memory");
            const unsigned og = xb_add(&bar[XB_TOP], 1u);
            const unsigned tg = og / nx;
            if (og + 1u == (tg + 1u) * nx) xb_add(&bar[XB_TOPGEN], 1u);
            else XB_SPIN(xb_ld(&bar[XB_TOPGEN]) == tg, bar);
            __builtin_amdgcn_fence(__ATOMIC_ACQUIRE, "agent");
            xb_add(&bar[XB_XGEN(b.x)], 1u);
            asm volatile("s_waitcnt vmcnt(0)" ::: "memory");
        } else {
            XB_SPIN(xb_ld(&bar[XB_XGEN(b.x)]) == gen, bar);
            __builtin_amdgcn_fence(__ATOMIC_ACQUIRE, "agent");
            asm volatile("s_waitcnt vmcnt(0)" ::: "memory");
        }
    }
    __syncthreads();
}

struct Frame {
    LAS unsigned char* lds;
    volatile LAS unsigned* MISC;
    gu32* ctl;
    int tid, lane, wave, vcu, G;
    const float* in[30]; float* out; unsigned char* ws;
};
enum { I_X = 0, I_C, I_POS, I_WMOD, I_BMOD, I_GPREMIX, I_WIN, I_MU, I_W0, I_WDEC, I_A0, I_WICLR, I_WGATE, I_KK, I_KA, I_RK, I_LNG, I_LNB, I_QNG, I_WQ, I_KVNG, I_WKV,
       I_WOUT, I_GPOSTMIX, I_GPREFFN, I_WUP, I_CONVW, I_CONVB, I_WDOWN, I_GPOSTFFN };
__constant__ float INV_FREQ[32] = {1.000000000e+00f, 7.498942018e-01f, 5.623413324e-01f, 4.216965139e-01f, 3.162277639e-01f, 2.371373773e-01f, 1.778279394e-01f, 1.333521456e-01f,
    1.000000015e-01f, 7.498942316e-02f, 5.623413250e-02f, 4.216964915e-02f, 3.162277490e-02f, 2.371373773e-02f, 1.778279431e-02f, 1.333521400e-02f, 9.999999776e-03f, 7.498942316e-03f,
    5.623413250e-03f, 4.216964822e-03f, 3.162277630e-03f, 2.371373819e-03f, 1.778279431e-03f, 1.333521446e-03f, 1.000000047e-03f, 7.498941850e-04f, 5.623413017e-04f, 4.216965172e-04f,
    3.162277571e-04f, 2.371373703e-04f, 1.778279402e-04f, 1.333521504e-04f};

__device__ __forceinline__ float modv(const Frame& F, int b, int n) {
    const float* mp = (const float*)(F.ws + WS_MODP) + (size_t)b * 12288 + n;
    return ((mp[0] + mp[4 * 12288]) + (mp[8 * 12288] + mp[12 * 12288])) + F.in[I_BMOD][n];
}

__device__ __forceinline__ void phase_mod(Frame& F) {
    LAS f32x4* sc = (LAS f32x4*)F.lds;
    const float* c = F.in[I_C];
    for (int k = F.tid; k < DM; k += NWAVES * 64) { f32x4 v;
#pragma unroll
        for (int b = 0; b < 4; ++b) { const float x = c[b * DM + k]; v[b] = x * fast_sigmoid(x); }
        sc[k] = v; }
    __syncthreads();
    LAS float* red = (LAS float*)(F.lds + 32768);
    const float* wm = F.in[I_WMOD];
    float* modp = (float*)(F.ws + WS_MODP);
    const int cq = F.lane & 15, rs = F.lane >> 4;
    for (int it = blockIdx.x; it < 768; it += F.G) {
        const int kc = it / 192, nc = it % 192;
        f32x4 acc[4];
#pragma unroll
        for (int b = 0; b < 4; ++b) acc[b] = (f32x4){0.f, 0.f, 0.f, 0.f};
        const int kb = kc * 512 + F.wave * 64 + rs;
#pragma unroll 8
        for (int i = 0; i < 16; ++i) { const int k = kb + 4 * i; const f32x4 w = *(const f32x4*)(wm + (size_t)k * 12288 + nc * 64 + 4 * cq); const f32x4 s = sc[k];
#pragma unroll
            for (int b = 0; b < 4; ++b) acc[b] += w * s[b]; }
#pragma unroll
        for (int b = 0; b < 4; ++b) {
#pragma unroll
            for (int e = 0; e < 4; ++e) { float v = acc[b][e]; v += __shfl_xor(v, 16); v += __shfl_xor(v, 32); acc[b][e] = v; }
            if (rs == 0) *(LAS f32x4*)(red + (F.wave * 4 + b) * 64 + 4 * cq) = acc[b];
        }
        __syncthreads();
        if (F.tid < 256) { const int b = F.tid >> 6, col = F.tid & 63; float s = 0.f;
#pragma unroll
            for (int w = 0; w < 8; ++w) s += red[(w * 4 + b) * 64 + col];
            modp[(size_t)(kc * 4 + b) * 12288 + nc * 64 + col] = s; }
        __syncthreads();
    }
}

__device__ __forceinline__ void transpose_item(const float* W, int N, int Kvalid, const float* kscale, bf16_t* WT, int ldk, int k0, int n0s, int n0d, LAS float* scr, int lane) {
#pragma unroll 8
    for (int i = 0; i < 32; ++i) { const int kk = 2 * i + (lane >> 5), k = k0 + kk; float v = 0.f;
        if (k < Kvalid) { v = W[(size_t)k * N + n0s + (lane & 31)]; if (kscale) v *= kscale[k]; }
        scr[kk * 33 + (lane & 31)] = v; }
    LDS_WAIT(); asm volatile("" ::: "memory");
    const int c = lane & 7;
#pragma unroll
    for (int j = 0; j < 4; ++j) { const int n = (lane >> 3) + 8 * j; const LAS float* s = scr + (8 * c) * 33 + n;
        u32x4 o; o.x = cvt_pk_bf16(s[0 * 33], s[1 * 33]); o.y = cvt_pk_bf16(s[2 * 33], s[3 * 33]); o.z = cvt_pk_bf16(s[4 * 33], s[5 * 33]); o.w = cvt_pk_bf16(s[6 * 33], s[7 * 33]);
        *(u32x4*)(WT + (size_t)(n0d + n) * ldk + k0 + 8 * c) = o; }
    LDS_WAIT(); asm volatile("" ::: "memory");
}
__device__ __forceinline__ void phase_weights(Frame& F) {
    LAS float* scr = (LAS float*)(F.lds + F.wave * 8704);
    const int gw = F.vcu * NWAVES + F.wave, NGW = F.G * NWAVES;
    constexpr int I0 = 32 * 136, I1 = 8 * 48, I2 = 4 * 64, I3 = 32 * 64, I4 = 32 * 352, I5 = 88 * 64, I6 = 2 * 32, I7 = 2 * 32, I8 = 4 * 32;
    constexpr int NITEMS = I0 + I1 + I2 + I3 + I4 + I5 + I6 + I7 + I8;
    for (int it = gw; it < NITEMS; it += NGW) {
        int r = it;
        if (r < I0) { const int kb = r / 136, nb = r % 136; transpose_item(F.in[I_WIN], IN_COLS, DM, nullptr, (bf16_t*)(F.ws + WS_WIN), DM, 64 * kb, 32 * nb, 32 * nb, scr, F.lane); continue; } r -= I0;
        if (r < I1) { const int kb = r / 48, nb = r % 48; transpose_item(F.in[I_WQ], QW, QLR, F.in[I_QNG], (bf16_t*)(F.ws + WS_WQ), QLR, 64 * kb, 32 * nb, 32 * nb, scr, F.lane); continue; } r -= I1;
        if (r < I2) { const int kb = r / 64, nb = r % 64; transpose_item(F.in[I_WKV], KVW, KVLR, F.in[I_KVNG], (bf16_t*)(F.ws + WS_WKV), KVLR, 64 * kb, 32 * nb, 32 * nb, scr, F.lane); continue; } r -= I2;
        if (r < I3) { const int kb = r / 64, nb = r % 64; transpose_item(F.in[I_WOUT], DM, DM, nullptr, (bf16_t*)(F.ws + WS_WOUT), DM, 64 * kb, 32 * nb, 32 * nb, scr, F.lane); continue; } r -= I3;
        if (r < I4) { const int kb = r / 352, nb = r % 352; const int n0d = 32 * nb, pn = n0d >> 8, bj = (n0d >> 7) & 1, j0 = n0d & 127;
                      transpose_item(F.in[I_WUP], UPW, DM, nullptr, (bf16_t*)(F.ws + WS_WUP), DM, 64 * kb, bj * DFF + 128 * pn + j0, n0d, scr, F.lane); continue; } r -= I4;
        if (r < I5) { const int kb = r / 64, nb = r % 64; transpose_item(F.in[I_WDOWN], DM, DFF, nullptr, (bf16_t*)(F.ws + WS_WDOWN), DFF, 64 * kb, 32 * nb, 32 * nb, scr, F.lane); continue; } r -= I5;
        if (r < I6) { const int kb = r / 32, nb = r % 32; transpose_item(F.in[I_WDEC], RW, 96, nullptr, (bf16_t*)(F.ws + WS_WDEC), 128, 64 * kb, 32 * nb, 32 * nb, scr, F.lane); continue; } r -= I6;
        if (r < I7) { const int kb = r / 32, nb = r % 32; transpose_item(F.in[I_WICLR], RW, 96, nullptr, (bf16_t*)(F.ws + WS_WICLR), 128, 64 * kb, 32 * nb, 32 * nb, scr, F.lane); continue; } r -= I7;
        { const int kb = r / 32, nb = r % 32; transpose_item(F.in[I_WGATE], RW, 256, nullptr, (bf16_t*)(F.ws + WS_WGATE), 256, 64 * kb, 32 * nb, 32 * nb, scr, F.lane); }
    }
}
__device__ __forceinline__ void phase_convcopy(Frame& F) {
    float* dst = (float*)(F.ws + WS_CONV);
    const int gt = F.vcu * NWAVES * 64 + F.tid, NT = F.G * NWAVES * 64;
    for (int i = gt; i < 4 * UPW; i += NT) dst[i] = (i < 3 * UPW) ? F.in[I_CONVW][i] : F.in[I_CONVB][i - 3 * UPW];
}
__device__ __forceinline__ void norm_mod_row(const float* xrow, bf16_t* orow, const LAS float* Am, const LAS float* Bm, int lane) {
    const f32x4* xr = (const f32x4*)xrow + lane;
    f32x4 v[8]; float s = 0.f;
#pragma unroll
    for (int j = 0; j < 8; ++j) { v[j] = xr[64 * j]; s += (v[j][0] * v[j][0] + v[j][1] * v[j][1]) + (v[j][2] * v[j][2] + v[j][3] * v[j][3]); }
    const float rstd = rsqrtf(wave_sum(s) * (1.f / DM) + NORM_EPS);
    u32x2* o8 = (u32x2*)orow + lane;
#pragma unroll
    for (int j = 0; j < 8; ++j) { const f32x4 a = *(const LAS f32x4*)(Am + 4 * (lane + 64 * j)), b = *(const LAS f32x4*)(Bm + 4 * (lane + 64 * j));
        const f32x4 y = v[j] * rstd * a + b; u32x2 w; w.x = cvt_pk_bf16(y[0], y[1]); w.y = cvt_pk_bf16(y[2], y[3]); o8[64 * j] = w; }
}
__device__ __forceinline__ void phase_hprep(Frame& F) {
    LAS float* Am = (LAS float*)(F.lds + 73728); LAS float* Bm = (LAS float*)(F.lds + 81920);
    const float* x = F.in[I_X]; bf16_t* H = (bf16_t*)(F.ws + WS_H);
    for (int rb = F.vcu; rb < TOK / 64; rb += F.G) {
        const int b = (rb * 64) / SEQ;
        __syncthreads();
        for (int k = F.tid; k < DM; k += NWAVES * 64) { Am[k] = F.in[I_GPREMIX][k] * (1.f + modv(F, b, 2048 + k)); Bm[k] = modv(F, b, k); }
        __syncthreads();
        for (int rr = F.wave; rr < 64; rr += NWAVES) { const size_t row = (size_t)rb * 64 + rr; norm_mod_row(x + row * DM, H + row * DM, Am, Bm, F.lane); }
    }
}

__device__ __forceinline__ void phase_tokprep(Frame& F) {
    const bf16_t* P = (const bf16_t*)(F.ws + WS_P);
    float* rq = (float*)(F.ws + WS_RSTDQ); float* rkv = (float*)(F.ws + WS_RSTDKV);
    bf16_t* KR = (bf16_t*)(F.ws + WS_KR); f32x2* CS = (f32x2*)(F.ws + WS_CS); bf16_t* LA = (bf16_t*)(F.ws + WS_LA);
    const int* pos = (const int*)F.in[I_POS]; const float* mu = F.in[I_MU];
    const int gw = F.vcu * NWAVES + F.wave, NGW = F.G * NWAVES, lane = F.lane;
    for (int row = gw; row < TOK; row += NGW) {
        const bf16_t* pr = P + (size_t)row * IN_COLS; const bool hp = (row % SEQ) != 0; const bf16_t* pp = pr - IN_COLS;
        { const u32x4 q = *(const u32x4*)(pr + C_QL + lane * 8); float s = 0.f;
#pragma unroll
          for (int i = 0; i < 4; ++i) { const float a = bflo(q[i]), b = bfhi(q[i]); s += a * a + b * b; }
          s = wave_sum(s); if (lane == 0) rq[row] = rsqrtf(s * (1.f / QLR) + NORM_EPS); }
        { const u32x2 q = *(const u32x2*)(pr + C_KVL + lane * 4); float s = 0.f;
#pragma unroll
          for (int i = 0; i < 2; ++i) { const float a = bflo(q[i]), b = bfhi(q[i]); s += a * a + b * b; }
          s = wave_sum(s); if (lane == 0) rkv[row] = rsqrtf(s * (1.f / KVLR) + NORM_EPS); }
        if (lane < 32) {
            const float ang = (float)pos[row] * INV_FREQ[lane];
            double a = (double)ang * 0.15915494309189535; a -= __builtin_rint(a); const float fr = (float)a;
            const float cs = __builtin_amdgcn_cosf(fr), sn = __builtin_amdgcn_sinf(fr);
            const float u1 = bf2f(pr[C_KR + lane]), u2 = bf2f(pr[C_KR + 32 + lane]);
            KR[(size_t)row * 64 + lane] = f2bf(u1 * cs - u2 * sn); KR[(size_t)row * 64 + 32 + lane] = f2bf(u1 * sn + u2 * cs);
            CS[(size_t)row * 32 + lane] = (f32x2){cs, sn};
        }
        bf16_t* la = LA + (size_t)row * LAW;
        if (lane < 48) {
#pragma unroll
            for (int part = 0; part < 2; ++part) { const int c0 = (part ? C_AD : C_WD) + 2 * lane;
                const unsigned cur = *(const unsigned*)(pr + c0); const unsigned prv = hp ? *(const unsigned*)(pp + c0) : 0u;
                const float m0 = mu[c0], m1 = mu[c0 + 1];
                float v0 = bflo(cur), v1 = bfhi(cur); v0 += (bflo(prv) - v0) * m0; v1 += (bfhi(prv) - v1) * m1;
                if (part == 0) { v0 = fast_tanh(v0); v1 = fast_tanh(v1); }
                *(unsigned*)(la + part * 128 + 2 * lane) = cvt_pk_bf16(v0, v1); }
        } else {
            *(unsigned*)(la + 96 + 2 * (lane - 48)) = 0u; *(unsigned*)(la + 128 + 96 + 2 * (lane - 48)) = 0u;
        }
        { const int c0 = C_GD + 4 * lane; const u32x2 cur = *(const u32x2*)(pr + c0); u32x2 prv = (u32x2){0u, 0u}; if (hp) prv = *(const u32x2*)(pp + c0);
          const f32x4 m = *(const f32x4*)(mu + c0);
          float v0 = bflo(cur.x), v1 = bfhi(cur.x), v2 = bflo(cur.y), v3 = bfhi(cur.y);
          v0 += (bflo(prv.x) - v0) * m[0]; v1 += (bfhi(prv.x) - v1) * m[1]; v2 += (bflo(prv.y) - v2) * m[2]; v3 += (bfhi(prv.y) - v3) * m[3];
          u32x2 w; w.x = cvt_pk_bf16(fast_sigmoid(v0), fast_sigmoid(v1)); w.y = cvt_pk_bf16(fast_sigmoid(v2), fast_sigmoid(v3));
          *(u32x2*)(la + 256 + 4 * lane) = w; }
    }
}

__device__ __forceinline__ void phase_mid(Frame& F) {
    LAS float* Gm = (LAS float*)(F.lds + 0); LAS float* Af = (LAS float*)(F.lds + 8192); LAS float* Bf = (LAS float*)(F.lds + 16384);
    const float* x = F.in[I_X]; bf16_t* H = (bf16_t*)(F.ws + WS_H); const bf16_t* O1 = (const bf16_t*)(F.ws + WS_O1); const float* ssq = (const float*)(F.ws + WS_SSQ1);
    const int lane = F.lane;
    for (int rb = F.vcu; rb < TOK / 64; rb += F.G) {
        const int b = (rb * 64) / SEQ;
        __syncthreads();
        for (int k = F.tid; k < DM; k += NWAVES * 64) { Gm[k] = F.in[I_GPOSTMIX][k] * modv(F, b, 4096 + k); Af[k] = F.in[I_GPREFFN][k] * (1.f + modv(F, b, 8192 + k)); Bf[k] = modv(F, b, 6144 + k); }
        __syncthreads();
        for (int rr = F.wave; rr < 64; rr += NWAVES) {
            const size_t row = (size_t)rb * 64 + rr;
            float sq = (lane < 32) ? ssq[row * 32 + lane] : 0.f; sq = wave_sum(sq);
            const float rstd1 = rsqrtf(sq * (1.f / DM) + NORM_EPS);
            const f32x4* xr = (const f32x4*)(x + row * DM) + lane; const u32x2* orow = (const u32x2*)(O1 + row * DM) + lane; f32x4* xo = (f32x4*)(F.out + row * DM) + lane;
            f32x4 v[8]; float s = 0.f;
#pragma unroll
            for (int j = 0; j < 8; ++j) { const f32x4 xv = xr[64 * j]; const u32x2 ov = orow[64 * j]; const f32x4 g = *(const LAS f32x4*)(Gm + 4 * (lane + 64 * j));
                f32x4 o; o[0] = bflo(ov.x); o[1] = bfhi(ov.x); o[2] = bflo(ov.y); o[3] = bfhi(ov.y);
                v[j] = xv + g * (o * rstd1); xo[64 * j] = v[j];
                s += (v[j][0] * v[j][0] + v[j][1] * v[j][1]) + (v[j][2] * v[j][2] + v[j][3] * v[j][3]); }
            const float rstd2 = rsqrtf(wave_sum(s) * (1.f / DM) + NORM_EPS);
            u32x2* o8 = (u32x2*)(H + row * DM) + lane;
#pragma unroll
            for (int j = 0; j < 8; ++j) { const f32x4 a = *(const LAS f32x4*)(Af + 4 * (lane + 64 * j)), bb = *(const LAS f32x4*)(Bf + 4 * (lane + 64 * j));
                const f32x4 y = v[j] * rstd2 * a + bb; u32x2 w; w.x = cvt_pk_bf16(y[0], y[1]); w.y = cvt_pk_bf16(y[2], y[3]); o8[64 * j] = w; }
        }
    }
}

__device__ __forceinline__ void phase_fixup(Frame& F) {
    const float* HEADB = (const float*)(F.ws + WS_HEAD); const float* TAILB = (const float*)(F.ws + WS_TAIL); bf16_t* ACT = (bf16_t*)(F.ws + WS_ACT);
    const float* cw = (const float*)(F.ws + WS_CONV); const float* cb = cw + 3 * UPW;
    const int gt = F.vcu * NWAVES * 64 + F.tid, NT = F.G * NWAVES * 64;
    for (int i = gt; i < 64 * 2 * DFF; i += NT) {
        const int cc = i % DFF, rr = (i / DFF) & 1, pm = i / (2 * DFF);
        if ((pm & 15) == 0) continue;
        const int ng = 256 * (cc >> 7) + (cc & 127), nv = ng + 128;
        const float* h0 = HEADB + ((size_t)pm * 2 + 0) * UPW; const float* h1 = h0 + UPW; const float* t0 = TAILB + ((size_t)(pm - 1) * 2 + 0) * UPW; const float* t1 = t0 + UPW;
        float ug, uv, pg1, pg2, pv1, pv2;
        if (rr == 0) { ug = h0[ng]; uv = h0[nv]; pg1 = t1[ng]; pv1 = t1[nv]; pg2 = t0[ng]; pv2 = t0[nv]; }
        else { ug = h1[ng]; uv = h1[nv]; pg1 = h0[ng]; pv1 = h0[nv]; pg2 = t1[ng]; pv2 = t1[nv]; }
        const float gc = fmaf(cw[cc], pg2, fmaf(cw[UPW + cc], pg1, fmaf(cw[2 * UPW + cc], ug, cb[cc])));
        const float vc = fmaf(cw[DFF + cc], pv2, fmaf(cw[UPW + DFF + cc], pv1, fmaf(cw[2 * UPW + DFF + cc], uv, cb[DFF + cc])));
        ACT[(size_t)(pm * 256 + rr) * DFF + cc] = f2bf(gelu_tanh(gc) * vc);
    }
}

__device__ __forceinline__ void phase_final(Frame& F) {
    LAS float* Gm = (LAS float*)(F.lds + 0);
    const bf16_t* O2 = (const bf16_t*)(F.ws + WS_O2); const float* ssq = (const float*)(F.ws + WS_SSQ2);
    const int lane = F.lane;
    for (int rb = F.vcu; rb < TOK / 64; rb += F.G) {
        const int b = (rb * 64) / SEQ;
        __syncthreads();
        for (int k = F.tid; k < DM; k += NWAVES * 64) Gm[k] = F.in[I_GPOSTFFN][k] * modv(F, b, 10240 + k);
        __syncthreads();
        for (int rr = F.wave; rr < 64; rr += NWAVES) {
            const size_t row = (size_t)rb * 64 + rr;
            float sq = (lane < 32) ? ssq[row * 32 + lane] : 0.f; sq = wave_sum(sq);
            const float rstd = rsqrtf(sq * (1.f / DM) + NORM_EPS);
            const u32x2* orow = (const u32x2*)(O2 + row * DM) + lane; f32x4* xo = (f32x4*)(F.out + row * DM) + lane;
#pragma unroll
            for (int j = 0; j < 8; ++j) { const f32x4 xv = xo[64 * j]; const u32x2 ov = orow[64 * j]; const f32x4 g = *(const LAS f32x4*)(Gm + 4 * (lane + 64 * j));
                f32x4 o; o[0] = bflo(ov.x); o[1] = bfhi(ov.x); o[2] = bflo(ov.y); o[3] = bfhi(ov.y);
                xo[64 * j] = xv + g * (o * rstd); }
        }
    }
}
namespace att {
constexpr int NW = 8, QBLK = 32, KVBLK = 64;
constexpr int SHM_V = 16384, SHM_K = 16384, SHM_KR = 8192;
constexpr int OFF_V = 0, OFF_K = 2 * SHM_V, OFF_KR = OFF_K + 2 * SHM_K, OFF_WS = OFF_KR + 2 * SHM_KR, SHM_ATTN = OFF_WS + NW * 64 * 4;
constexpr float THR = 8.f;
#define KSWZ(row, colB) ((row) * 256 + ((colB) ^ (((row) & 7) << 4)))
#define KRSWZ(row, colB) ((row) * 128 + ((colB) ^ ((((row) >> 1) & 7) << 4)))
#define SBAR() __builtin_amdgcn_sched_barrier(0)
__device__ __forceinline__ int crow(int r, int hi) { return (r & 3) + 8 * (r >> 2) + 4 * hi; }
__device__ __forceinline__ void partialSM(f32x16& p0, f32x16& p1, float& m_reg, float& mn, float& alpha) {
    float pmax = p0[0];
#pragma unroll
    for (int r = 1; r < 16; ++r) pmax = fmaxf(pmax, p0[r]);
#pragma unroll
    for (int r = 0; r < 16; ++r) pmax = fmaxf(pmax, p1[r]);
    { auto rr = __builtin_amdgcn_permlane32_swap(__float_as_uint(pmax), __float_as_uint(pmax), false, false);
      pmax = fmaxf(__uint_as_float(rr[0]), __uint_as_float(rr[1])); }
    if (__builtin_expect(__all(pmax - m_reg <= THR), 1)) { mn = m_reg; alpha = 1.f; }
    else { mn = fmaxf(m_reg, pmax); alpha = __builtin_amdgcn_exp2f(m_reg - mn); m_reg = mn; }
#pragma unroll
    for (int r = 0; r < 16; ++r) { p0[r] = p0[r] - mn; p1[r] = p1[r] - mn; }
#pragma unroll
    for (int r = 0; r < 16; ++r) p0[r] = __builtin_amdgcn_exp2f(p0[r]);
}
__device__ __forceinline__ void finishSM(f32x16& p0, f32x16& p1, float alpha, float& l_reg, bf16x8& pa0, bf16x8& pa1, bf16x8& pa2, bf16x8& pa3) {
#pragma unroll
    for (int r = 0; r < 16; ++r) p1[r] = __builtin_amdgcn_exp2f(p1[r]);
    float ps = 0;
#pragma unroll
    for (int r = 0; r < 16; ++r) ps += p0[r];
#pragma unroll
    for (int r = 0; r < 16; ++r) ps += p1[r];
    { auto rr = __builtin_amdgcn_permlane32_swap(__float_as_uint(ps), __float_as_uint(ps), false, false);
      ps = __uint_as_float(rr[0]) + __uint_as_float(rr[1]); }
    l_reg = l_reg * alpha + ps;
#define PK4(P, BASE, OUT) do { unsigned a0 = cvt_pk_bf16(P[BASE + 0], P[BASE + 1]), a1 = cvt_pk_bf16(P[BASE + 2], P[BASE + 3]);   \
    unsigned b0 = cvt_pk_bf16(P[BASE + 4], P[BASE + 5]), b1 = cvt_pk_bf16(P[BASE + 6], P[BASE + 7]);                              \
    auto r0 = __builtin_amdgcn_permlane32_swap(a0, b0, false, false); auto r1 = __builtin_amdgcn_permlane32_swap(a1, b1, false, false); \
    u32x4 w = {r0[0], r1[0], r0[1], r1[1]}; OUT = *reinterpret_cast<bf16x8*>(&w); } while (0)
    PK4(p0, 0, pa0); PK4(p0, 8, pa1); PK4(p1, 0, pa2); PK4(p1, 8, pa3);
#undef PK4
}
__device__ __forceinline__ void qkt(f32x16& p0, f32x16& p1, const char* Ks, const char* KRs, const bf16x8* qr, int r32, int hi) {
    p0 = f32x16{}; p1 = f32x16{};
#pragma unroll
    for (int d0 = 0; d0 < 8; ++d0) { const int cb = (d0 * 16 + hi * 8) * 2;
        const bf16x8 b0 = *reinterpret_cast<const bf16x8*>(Ks + KSWZ(r32, cb));
        const bf16x8 b1 = *reinterpret_cast<const bf16x8*>(Ks + KSWZ(32 + r32, cb));
        p0 = __builtin_amdgcn_mfma_f32_32x32x16_bf16(b0, qr[d0], p0, 0, 0, 0);
        p1 = __builtin_amdgcn_mfma_f32_32x32x16_bf16(b1, qr[d0], p1, 0, 0, 0); }
#pragma unroll
    for (int d0 = 0; d0 < 4; ++d0) { const int cb = (d0 * 16 + hi * 8) * 2;
        const bf16x8 b0 = *reinterpret_cast<const bf16x8*>(KRs + KRSWZ(r32, cb));
        const bf16x8 b1 = *reinterpret_cast<const bf16x8*>(KRs + KRSWZ(32 + r32, cb));
        p0 = __builtin_amdgcn_mfma_f32_32x32x16_bf16(b0, qr[8 + d0], p0, 0, 0, 0);
        p1 = __builtin_amdgcn_mfma_f32_32x32x16_bf16(b1, qr[8 + d0], p1, 0, 0, 0); }
}
__device__ __forceinline__ int v_st(int k, int c) { const int kk = (k & ~0xC) | ((k & 4) << 1) | ((k & 8) >> 1); return ((kk >> 3) * 4 + (c >> 5)) * 512 + ((kk & 7) * 32 + (c & 31)) * 2; }
__device__ __forceinline__ int v_rd_base(int lane) { return ((lane & 3) << 3) | (((lane >> 2) & 3) << 6) | (((lane >> 4) & 1) << 5) | (((lane >> 5) & 1) << 8); }
constexpr int v_rd_off(int d0, int ks, int half) { return d0 * 512 + ks * 4096 + half * 2048; }
template <int OFF> __device__ __forceinline__ s16x4 tr_read(int vb) {
    s16x4 r; asm volatile("ds_read_b64_tr_b16 %0, %1 offset:%2" : "=&v"(r) : "v"(vb), "i"(OFF) : "memory"); return r;
}
template <int D0> __device__ __forceinline__ void pv_one(f32x16& od, int vb, bf16x8 pa0, bf16x8 pa1, bf16x8 pa2, bf16x8 pa3) {
    const s16x4 l0 = tr_read<v_rd_off(D0, 0, 0)>(vb), h0 = tr_read<v_rd_off(D0, 0, 1)>(vb), l1 = tr_read<v_rd_off(D0, 1, 0)>(vb), h1 = tr_read<v_rd_off(D0, 1, 1)>(vb);
    const s16x4 l2 = tr_read<v_rd_off(D0, 2, 0)>(vb), h2 = tr_read<v_rd_off(D0, 2, 1)>(vb), l3 = tr_read<v_rd_off(D0, 3, 0)>(vb), h3 = tr_read<v_rd_off(D0, 3, 1)>(vb);
    asm volatile("s_waitcnt lgkmcnt(0)" ::: "memory"); SBAR();
#define PK(L, H) (bf16x8){L[0], L[1], L[2], L[3], H[0], H[1], H[2], H[3]}
    od = __builtin_amdgcn_mfma_f32_32x32x16_bf16(pa0, PK(l0, h0), od, 0, 0, 0);
    od = __builtin_amdgcn_mfma_f32_32x32x16_bf16(pa1, PK(l1, h1), od, 0, 0, 0);
    od = __builtin_amdgcn_mfma_f32_32x32x16_bf16(pa2, PK(l2, h2), od, 0, 0, 0);
    od = __builtin_amdgcn_mfma_f32_32x32x16_bf16(pa3, PK(l3, h3), od, 0, 0, 0);
#undef PK
}
__device__ __forceinline__ void pv_d0(f32x16* o, int vb, bf16x8 pa0, bf16x8 pa1, bf16x8 pa2, bf16x8 pa3) {
    pv_one<0>(o[0], vb, pa0, pa1, pa2, pa3); pv_one<1>(o[1], vb, pa0, pa1, pa2, pa3); pv_one<2>(o[2], vb, pa0, pa1, pa2, pa3); pv_one<3>(o[3], vb, pa0, pa1, pa2, pa3);
}

__device__ __forceinline__ void attn_unit(int b, int h, int qb, const bf16_t* __restrict__ Qg, const bf16_t* __restrict__ KVg, const bf16_t* __restrict__ KRg, const f32x2* __restrict__ CSg,
                                          bf16_t* __restrict__ Yg, char* lds) {
    const int tid = threadIdx.x, wid = __builtin_amdgcn_readfirstlane(tid >> 6), lane = tid & 63, r32 = lane & 31, hi = lane >> 5;
    char* V_lds = lds + OFF_V; char* K_lds = lds + OFF_K; char* KR_lds = lds + OFF_KR;
    float* ws = (float*)(lds + OFF_WS) + wid * 64; float* li_l = ws; float* al_l = ws + 32;
    const int q0 = qb * 256, NT = 4 * qb + 4, nt_w = 4 * qb + (wid >> 1) + 1;
    const size_t tok0 = (size_t)b * SEQ;
    float m_reg = -1e30f, l_reg = 0; f32x16 o[4] = {}; bf16x8 qr[12];
    { const size_t qrow = tok0 + q0 + wid * QBLK + r32;
      const bf16_t* Qw = Qg + qrow * QW + h * QHD + hi * 8;
#pragma unroll
      for (int d0 = 0; d0 < 12; ++d0) qr[d0] = *reinterpret_cast<const bf16x8*>(Qw + d0 * 16);
      const f32x2* cs = CSg + qrow * 32 + hi * 8;
#pragma unroll
      for (int dd = 0; dd < 2; ++dd) {
          bf16x8 x1 = qr[8 + dd], x2 = qr[10 + dd]; float y1[8], y2[8];
#pragma unroll
          for (int j = 0; j < 8; ++j) { const f32x2 c = cs[dd * 16 + j]; const float a = bf2f((unsigned short)x1[j]), bb = bf2f((unsigned short)x2[j]);
              y1[j] = a * c[0] - bb * c[1]; y2[j] = a * c[1] + bb * c[0]; }
          u32x4 w1 = {cvt_pk_bf16(y1[0], y1[1]), cvt_pk_bf16(y1[2], y1[3]), cvt_pk_bf16(y1[4], y1[5]), cvt_pk_bf16(y1[6], y1[7])};
          u32x4 w2 = {cvt_pk_bf16(y2[0], y2[1]), cvt_pk_bf16(y2[2], y2[3]), cvt_pk_bf16(y2[4], y2[5]), cvt_pk_bf16(y2[6], y2[7])};
          qr[8 + dd] = *reinterpret_cast<bf16x8*>(&w1); qr[10 + dd] = *reinterpret_cast<bf16x8*>(&w2);
      } }
    const bf16_t* Kh = KVg + tok0 * KVW + h * 256; const bf16_t* Vh = Kh + 128; const bf16_t* KRb = KRg + tok0 * 64;
    const int sr = tid >> 4, sc = (tid & 15) * 8, vst0 = v_st(sr, sc), vst1 = v_st(32 + sr, sc);
    const int krr = tid >> 3, krc = (tid & 7) * 8;
    const int vb0 = (int)(uintptr_t)V_lds + v_rd_base(lane);
    bf16x8 s_vs0, s_vs1, s_ks0, s_ks1, s_kr;
#define SLOAD(k0) do { s_vs0 = *reinterpret_cast<const bf16x8*>(&Vh[(size_t)((k0) + sr) * KVW + sc]); s_vs1 = *reinterpret_cast<const bf16x8*>(&Vh[(size_t)((k0) + 32 + sr) * KVW + sc]); \
    s_ks0 = *reinterpret_cast<const bf16x8*>(&Kh[(size_t)((k0) + sr) * KVW + sc]); s_ks1 = *reinterpret_cast<const bf16x8*>(&Kh[(size_t)((k0) + 32 + sr) * KVW + sc]); \
    s_kr = *reinterpret_cast<const bf16x8*>(&KRb[(size_t)((k0) + krr) * 64 + krc]); } while (0)
#define SWRITE(bb) do { *(bf16x8*)(V_lds + (bb) * SHM_V + vst0) = s_vs0; *(bf16x8*)(V_lds + (bb) * SHM_V + vst1) = s_vs1; const int kc = sc * 2; \
    *(bf16x8*)(K_lds + (bb) * SHM_K + KSWZ(sr, kc)) = s_ks0; *(bf16x8*)(K_lds + (bb) * SHM_K + KSWZ(32 + sr, kc)) = s_ks1; \
    *(bf16x8*)(KR_lds + (bb) * SHM_KR + KRSWZ(krr, krc * 2)) = s_kr; } while (0)
#define SWAIT() asm volatile("s_waitcnt vmcnt(0)" ::: "memory")
#define RESC(a) do { if (__any((a) < 1.f)) { if (hi == 0) al_l[r32] = (a); asm volatile("s_waitcnt lgkmcnt(0)" ::: "memory"); \
    _Pragma("unroll") for (int d = 0; d < 4; ++d) _Pragma("unroll") for (int r = 0; r < 16; ++r) o[d][r] *= al_l[crow(r, hi)]; } } while (0)
#define ACTV(j) ((j) < nt_w)
    f32x16 p0, p1; float mn, al = 1.f; bf16x8 pa0, pa1, pa2, pa3;
    SLOAD(0); SWAIT(); SWRITE(0); __syncthreads();
    for (int j = 0; j < NT; ++j) {
        const int bsel = j & 1;
        if (j + 1 < NT) SLOAD((j + 1) * KVBLK);
        if (ACTV(j)) {
            qkt(p0, p1, K_lds + bsel * SHM_K, KR_lds + bsel * SHM_KR, qr, r32, hi);
            partialSM(p0, p1, m_reg, mn, al);
            RESC(al);
            finishSM(p0, p1, al, l_reg, pa0, pa1, pa2, pa3); SBAR();
            pv_d0(o, vb0 + bsel * SHM_V, pa0, pa1, pa2, pa3);
        }
        if (j + 1 < NT) { SWAIT(); SWRITE(bsel ^ 1); }
        __syncthreads();
    }
    if (hi == 0) li_l[r32] = l_reg; asm volatile("s_waitcnt lgkmcnt(0)" ::: "memory");
    float rli[16];
#pragma unroll
    for (int r = 0; r < 16; ++r) rli[r] = __builtin_amdgcn_rcpf(li_l[crow(r, hi)]);
    bf16_t* Yw = Yg + (tok0 + q0 + wid * QBLK) * DM + RW + h * DV;
#pragma unroll
    for (int r = 0; r < 16; ++r) { const int orow = crow(r, hi);
#pragma unroll
        for (int d0 = 0; d0 < 4; ++d0) Yw[(size_t)orow * DM + d0 * 32 + r32] = f2bf(o[d0][r] * rli[r]); }
    __syncthreads();
#undef SLOAD
#undef SWRITE
#undef SWAIT
#undef RESC
#undef ACTV
}
#undef SBAR
}
namespace rk {
constexpr int LDM = 72, MB = 64 * LDM * 2;
constexpr int FP = 68;
struct Bufs { bf16_t* G; bf16_t* H; bf16_t* Qe; bf16_t* Yi; bf16_t* S0; float* PC; float* BON; };
__device__ __forceinline__ LAS char* mbuf(LAS unsigned char* lds, int i) { return (LAS char*)lds + i * MB; }

__device__ __forceinline__ f32x4 tile64(const LAS char* Aq, const LAS char* Bp, int tq, int tp, int lane, f32x4 acc) {
    const int r = lane & 15, kq = lane >> 4;
    const LAS char* ap = Aq + (tq * 16 + r) * (LDM * 2) + kq * 16; const LAS char* bp = Bp + (tp * 16 + r) * (LDM * 2) + kq * 16;
    const bf16x8 a0 = *(const LAS bf16x8*)ap, a1 = *(const LAS bf16x8*)(ap + 64), b0 = *(const LAS bf16x8*)bp, b1 = *(const LAS bf16x8*)(bp + 64);
    acc = __builtin_amdgcn_mfma_f32_16x16x32_bf16(a0, b0, acc, 0, 0, 0);
    return __builtin_amdgcn_mfma_f32_16x16x32_bf16(a1, b1, acc, 0, 0, 0);
}
__device__ __forceinline__ void st_pq(LAS char* dst, int tq, int tp, int lane, f32x4 v) {
    u32x2 w; w.x = cvt_pk_bf16(v[0], v[1]); w.y = cvt_pk_bf16(v[2], v[3]);
    *(LAS u32x2*)(dst + (tp * 16 + (lane & 15)) * (LDM * 2) + (tq * 16 + 4 * (lane >> 4)) * 2) = w;
}
__device__ __forceinline__ void st_qp(LAS char* dstT, int tq, int tp, int lane, f32x4 v) {
#pragma unroll
    for (int e = 0; e < 4; ++e) *(LAS bf16_t*)(dstT + (tq * 16 + 4 * (lane >> 4) + e) * (LDM * 2) + (tp * 16 + (lane & 15)) * 2) = f2bf(v[e]);
}
__device__ __forceinline__ f32x4 ld_pq(const LAS char* src, int tq, int tp, int lane) {
    const u32x2 w = *(const LAS u32x2*)(src + (tp * 16 + (lane & 15)) * (LDM * 2) + (tq * 16 + 4 * (lane >> 4)) * 2);
    return (f32x4){bflo(w.x), bfhi(w.x), bflo(w.y), bfhi(w.y)};
}
__device__ __forceinline__ void gst_pq(bf16_t* dst, int tq, int tp, int lane, f32x4 v) {
    u32x2 w; w.x = cvt_pk_bf16(v[0], v[1]); w.y = cvt_pk_bf16(v[2], v[3]);
    *(u32x2*)(dst + (tp * 16 + (lane & 15)) * 64 + tq * 16 + 4 * (lane >> 4)) = w;
}
#define RK_BAR() do { asm volatile("s_waitcnt lgkmcnt(0)" ::: "memory"); __builtin_amdgcn_s_barrier(); asm volatile("" ::: "memory"); } while (0)

#if MK_CHECK
__device__ __forceinline__ void dbg_scan(Frame& F, int buf, int slot) {
    unsigned* fl = (unsigned*)(F.ws + WS_CTL) + 8 + 2 * slot; const LAS char* m = mbuf(F.lds, buf) + (F.tid >> 3) * (LDM * 2) + (F.tid & 7) * 16;
    const u32x4 w = *(const LAS u32x4*)m; float mx = 0.f; bool nf = false;
#pragma unroll
    for (int j = 0; j < 4; ++j) { const float a = bflo(w[j]), b = bfhi(w[j]); if (!(fabsf(a) <= 3e38f) || !(fabsf(b) <= 3e38f)) nf = true; else mx = fmaxf(mx, fmaxf(fabsf(a), fabsf(b))); }
    if (nf) atomicOr(fl, 1u); atomicMax(fl + 1, __float_as_uint(mx));
}
#define DBG(buf, slot) do { if ((slot) == MK_RPT) dbg_scan(F, buf, slot); } while (0)
#else
#define DBG(buf, slot) do { } while (0)
#endif
__device__ __forceinline__ void prep_item(Frame& F, const Bufs& B, int item) {
    const int tid = F.tid, lane = F.lane, wave = F.wave;
    const int bh = item >> 6, ch = item & 63, b = bh >> 4, h = bh & 15;
    const size_t tok0 = (size_t)b * SEQ + ch * 64;
    const bf16_t* P = (const bf16_t*)(F.ws + WS_P); const bf16_t* LA = (const bf16_t*)(F.ws + WS_LA);
    LAS unsigned char* lds = F.lds;
    LAS float* LDf = (LAS float*)(lds + 8 * MB);
    LAS float* AF = (LAS float*)(lds + 10 * MB);
    LAS float* SEG = (LAS float*)(lds + 12 * MB);
    {
        const int which = wave >> 2, tp = wave & 3;
        const bf16_t* Ar = LA + (tok0 + tp * 16 + (lane & 15)) * LAW + which * 128 + (lane >> 4) * 8;
        const bf16_t* Wt = (const bf16_t*)(F.ws + (which ? WS_WICLR : WS_WDEC)) + (size_t)(h * 64 + (lane & 15)) * 128 + (lane >> 4) * 8;
        bf16x8 bfr[3];
#pragma unroll
        for (int ks = 0; ks < 3; ++ks) bfr[ks] = *(const bf16x8*)(Ar + ks * 32);
        LAS float* dst = which ? AF : LDf;
#pragma unroll
        for (int tq = 0; tq < 4; ++tq) {
            f32x4 acc = (f32x4){0.f, 0.f, 0.f, 0.f};
#pragma unroll
            for (int ks = 0; ks < 3; ++ks) { const bf16x8 afr = *(const bf16x8*)(Wt + (size_t)tq * 16 * 128 + ks * 32); acc = __builtin_amdgcn_mfma_f32_16x16x32_bf16(afr, bfr[ks], acc, 0, 0, 0); }
            *(LAS f32x4*)(dst + (tp * 16 + (lane & 15)) * FP + tq * 16 + 4 * (lane >> 4)) = acc;
        }
    }
    RK_BAR();
    const int ti = tid >> 3, c8 = (tid & 7) * 8, col = h * 64 + c8;
    float r[8], kx[8], v[8], ld[8], a[8];
    {
        const size_t row = tok0 + ti; const bf16_t* pr = P + row * IN_COLS; const bool hp = (ch * 64 + ti) > 0;
        const u32x4 cr = *(const u32x4*)(pr + C_R + col), ck = *(const u32x4*)(pr + C_K + col), cv = *(const u32x4*)(pr + C_V + col);
        u32x4 qr_ = (u32x4){0u, 0u, 0u, 0u}, qk_ = qr_, qv_ = qr_;
        if (hp) { qr_ = *(const u32x4*)(pr - IN_COLS + C_R + col); qk_ = *(const u32x4*)(pr - IN_COLS + C_K + col); qv_ = *(const u32x4*)(pr - IN_COLS + C_V + col); }
        const float* mu = F.in[I_MU];
#pragma unroll
        for (int j = 0; j < 4; ++j) {
            float c0 = bflo(cr[j]), c1 = bfhi(cr[j]); r[2 * j] = c0 + (bflo(qr_[j]) - c0) * mu[C_R + col + 2 * j]; r[2 * j + 1] = c1 + (bfhi(qr_[j]) - c1) * mu[C_R + col + 2 * j + 1];
            c0 = bflo(ck[j]); c1 = bfhi(ck[j]); kx[2 * j] = c0 + (bflo(qk_[j]) - c0) * mu[C_K + col + 2 * j]; kx[2 * j + 1] = c1 + (bfhi(qk_[j]) - c1) * mu[C_K + col + 2 * j + 1];
            c0 = bflo(cv[j]); c1 = bfhi(cv[j]); v[2 * j] = c0 + (bflo(qv_[j]) - c0) * mu[C_V + col + 2 * j]; v[2 * j + 1] = c1 + (bfhi(qv_[j]) - c1) * mu[C_V + col + 2 * j + 1];
        }
#pragma unroll
        for (int j = 0; j < 8; ++j) {
            const float z = LDf[ti * FP + c8 + j] + F.in[I_W0][col + j]; const float y = -z; const float sp = fmaxf(y, 0.f) + __logf(1.f + __expf(-fabsf(y)));
            ld[j] = -__expf(-sp - 0.5f);
            a[j] = fast_sigmoid(AF[ti * FP + c8 + j] + F.in[I_A0][col + j]);
        }
#pragma unroll
        for (int j = 0; j < 8; ++j) LDf[ti * FP + c8 + j] = ld[j];
    }
    RK_BAR();
    {
        const int k = tid & 63, seg = tid >> 6; float run = 0.f;
#pragma unroll
        for (int j = 0; j < 8; ++j) { run += LDf[(seg * 8 + j) * FP + k]; LDf[(seg * 8 + j) * FP + k] = run; }
        SEG[seg * 64 + k] = run;
    }
    RK_BAR();
    {
        float L[8], LC[8];
#pragma unroll
        for (int j = 0; j < 8; ++j) { float pre = 0.f, tot = 0.f;
#pragma unroll
            for (int s = 0; s < 8; ++s) { const float sv = SEG[s * 64 + c8 + j]; tot += sv; if (s < (ti >> 3)) pre += sv; }
            L[j] = LDf[ti * FP + c8 + j] + pre; LC[j] = tot; }
        float kk[8], km[8], ss = 0.f, bon = 0.f;
#pragma unroll
        for (int j = 0; j < 8; ++j) { kk[j] = kx[j] * F.in[I_KK][col + j]; ss += kk[j] * kk[j]; km[j] = kx[j] * (1.f + (a[j] - 1.f) * F.in[I_KA][col + j]); bon += r[j] * km[j] * F.in[I_RK][col + j]; }
        ss += __shfl_xor(ss, 1); ss += __shfl_xor(ss, 2); ss += __shfl_xor(ss, 4);
        bon += __shfl_xor(bon, 1); bon += __shfl_xor(bon, 2); bon += __shfl_xor(bon, 4);
        const float inv = 1.f / fmaxf(sqrtf(ss), 1e-12f);
        if ((tid & 7) == 0) B.BON[(tok0 + ti) * RH + h] = bon;
        if (ti == 63) {
#pragma unroll
            for (int j = 0; j < 8; ++j) B.PC[(size_t)item * 64 + c8 + j] = __expf(LC[j]);
        }
        float eL[8], eLx[8], eN[8], eC[8];
#pragma unroll
        for (int j = 0; j < 8; ++j) { kk[j] *= inv; eL[j] = __expf(L[j]); eLx[j] = __expf(L[j] - ld[j]); eN[j] = __expf(-L[j]); eC[j] = __expf(LC[j] - L[j]); }
#define PK8(x) (u32x4){cvt_pk_bf16(x[0], x[1]), cvt_pk_bf16(x[2], x[3]), cvt_pk_bf16(x[4], x[5]), cvt_pk_bf16(x[6], x[7])}
#define ST_TOK(buf, x) *(LAS u32x4*)(mbuf(lds, buf) + ti * (LDM * 2) + c8 * 2) = PK8(x)
#define ST_CH(buf, x) do { _Pragma("unroll") for (int j = 0; j < 8; ++j) *(LAS bf16_t*)(mbuf(lds, buf) + (c8 + j) * (LDM * 2) + ti * 2) = f2bf(x[j]); } while (0)
#define FENCE() asm volatile("" ::: "memory")
        { float x[8];
#pragma unroll
          for (int j = 0; j < 8; ++j) x[j] = -kk[j] * eLx[j];
          ST_TOK(0, x); ST_CH(4, x); } FENCE();
        { float x[8];
#pragma unroll
          for (int j = 0; j < 8; ++j) x[j] = r[j] * eL[j];
          ST_TOK(1, x); } FENCE();
        { float x[8];
#pragma unroll
          for (int j = 0; j < 8; ++j) x[j] = MK_NODELTA ? 0.f : kk[j] * a[j] * eN[j];
          ST_TOK(2, x); } FENCE();
        { float x[8];
#pragma unroll
          for (int j = 0; j < 8; ++j) x[j] = km[j] * eN[j];
          ST_TOK(3, x); } FENCE();
        { float x[8];
#pragma unroll
          for (int j = 0; j < 8; ++j) x[j] = MK_NODELTA ? 0.f : kk[j] * a[j] * eC[j];
          ST_CH(5, x); } FENCE();
        { float x[8];
#pragma unroll
          for (int j = 0; j < 8; ++j) x[j] = km[j] * eC[j];
          ST_CH(6, x); } FENCE();
        ST_CH(7, v);
#undef PK8
#undef ST_TOK
#undef ST_CH
#undef FENCE
    }
    RK_BAR();
    DBG(0, 8); DBG(1, 9); DBG(2, 10); DBG(3, 11); DBG(4, 12); DBG(5, 13); DBG(6, 14); DBG(7, 15);
    const f32x4 Z = (f32x4){0.f, 0.f, 0.f, 0.f};
    {
        const int mi = wave >> 1;
        const LAS char* Bp = mbuf(lds, (mi < 2) ? 0 : 1); const LAS char* Aq = mbuf(lds, (mi & 1) ? 3 : 2);
        LAS char* dst = mbuf(lds, mi == 0 ? 8 : 9 + mi);
#pragma unroll 1
        for (int tt = 0; tt < 2; ++tt) { const int tp = 2 * (wave & 1) + tt;
#pragma unroll 1
            for (int tq = 0; tq < 4; ++tq) {
                f32x4 acc = Z;
                if (tq <= tp) acc = tile64(Aq, Bp, tq, tp, lane, acc);
                const int pi = tp * 16 + (lane & 15), qj = tq * 16 + 4 * (lane >> 4);
#pragma unroll
                for (int e = 0; e < 4; ++e) { const bool keep = (mi < 2) ? (qj + e < pi) : (qj + e <= pi); if (!keep) acc[e] = 0.f; }
                st_pq(dst, tq, tp, lane, acc);
            }
        }
    }
    for (int e = tid; e < MB / 16; e += NWAVES * 64) *(LAS u32x4*)(mbuf(lds, 9) + e * 16) = (u32x4){0u, 0u, 0u, 0u};
    RK_BAR();
    for (int e = tid; e < MB / 16; e += NWAVES * 64) { const u32x4 z4 = (u32x4){0u, 0u, 0u, 0u};
        *(LAS u32x4*)(mbuf(lds, 0) + e * 16) = z4; *(LAS u32x4*)(mbuf(lds, 2) + e * 16) = z4; *(LAS u32x4*)(mbuf(lds, 3) + e * 16) = z4; *(LAS u32x4*)(mbuf(lds, 14) + e * 16) = z4; }
    if (wave == 0) {
        const int blk = lane >> 4, c = lane & 15; float Tc[16];
        const LAS char* Pm = mbuf(lds, 8) + blk * 16 * (LDM * 2) + blk * 32;
#pragma unroll
        for (int i = 0; i < 16; ++i) {
            asm volatile("" ::: "memory");
            const u32x4 m0 = *(const LAS u32x4*)(Pm + i * (LDM * 2)), m1 = *(const LAS u32x4*)(Pm + i * (LDM * 2) + 16);
            float acc = (i == c) ? 1.f : 0.f;
#pragma unroll
            for (int j = 0; j < i; ++j) { const unsigned w = (j < 8) ? m0[(j >> 1) & 3] : m1[(j >> 1) & 3]; const float mij = (j & 1) ? bfhi(w) : bflo(w); acc = fmaf(mij, Tc[j], acc); }
            Tc[i] = acc;
        }
#pragma unroll
        for (int i = 0; i < 16; ++i) *(LAS bf16_t*)(mbuf(lds, 9) + (blk * 16 + i) * (LDM * 2) + (blk * 16 + c) * 2) = f2bf(Tc[i]);
    } else if (wave >= 4) {
        const int tp = wave & 3;
#pragma unroll
        for (int tq = 0; tq < 4; ++tq) { const f32x4 acc = tile64(mbuf(lds, 10), mbuf(lds, 7), tq, tp, lane, Z); st_pq(mbuf(lds, 13), tq, tp, lane, acc); }
    }
    RK_BAR();
#pragma unroll 1
    for (int ab = 0; ab < 4; ++ab) {
        const int which = wave >> 2, tp = wave & 3;
        {
            f32x4 acc = ld_pq(mbuf(lds, which ? 13 : 4), ab, tp, lane);
            if (ab > 0) acc = tile64(mbuf(lds, 8), mbuf(lds, which ? 3 : 2), ab, tp, lane, acc);
            st_pq(mbuf(lds, which ? 0 : 14), ab, tp, lane, acc);
        }
        RK_BAR();
        {
            const f32x4 acc = tile64(mbuf(lds, 9), mbuf(lds, which ? 0 : 14), ab, tp, lane, Z);
            st_pq(mbuf(lds, which ? 3 : 2), ab, tp, lane, acc);
#if MK_CHECK
            if (item == (3 * 16 + 15) * 64 && which) gst_pq((bf16_t*)(F.ws + WS_CTL + 32768), ab, tp, lane, acc);
#endif
        }
        RK_BAR();
    }
    DBG(8, 24); DBG(9, 25);
    {
        const int oi = wave >> 1; const size_t ob = (size_t)item * 4096;
#pragma unroll 1
        for (int tt = 0; tt < 2; ++tt) { const int tp = 2 * (wave & 1) + tt;
#pragma unroll 1
            for (int tq = 0; tq < 4; ++tq) {
                if (oi == 0) {
                    gst_pq(B.G + ob, tq, tp, lane, tile64(mbuf(lds, 2), mbuf(lds, 5), tq, tp, lane, Z));
                } else if (oi == 1) {
                    f32x4 acc = tile64(mbuf(lds, 5), mbuf(lds, 3), tq, tp, lane, Z); acc = tile64(mbuf(lds, 6), mbuf(lds, 7), tq, tp, lane, acc);
                    gst_pq(B.H + ob, tq, tp, lane, acc);
                } else if (oi == 2) {
                    f32x4 acc = ld_pq(mbuf(lds, 1), tq, tp, lane); acc = tile64(mbuf(lds, 2), mbuf(lds, 11), tq, tp, lane, acc);
                    gst_pq(B.Qe + ob, tq, tp, lane, acc);
                } else {
                    f32x4 acc = tile64(mbuf(lds, 3), mbuf(lds, 11), tq, tp, lane, Z); acc = tile64(mbuf(lds, 7), mbuf(lds, 12), tq, tp, lane, acc);
                    gst_pq(B.Yi + ob, tq, tp, lane, acc);
                }
            }
        }
    }
    RK_BAR();
}

__device__ __forceinline__ void scan_unit(const Bufs& B, int bh, int vq, int lane) {
    const int vl = lane & 15, q = lane >> 4, v = vq * 16 + vl;
    f32x4 S[4];
#pragma unroll
    for (int t = 0; t < 4; ++t) S[t] = (f32x4){0.f, 0.f, 0.f, 0.f};
    u32x2 gfr[4][2][2]; u32x2 hfr[4]; f32x4 pc[4];
#define RK_LOAD(c) do { const size_t it_ = (size_t)(bh * 64 + (c)); const bf16_t* Gp = B.G + it_ * 4096; const bf16_t* Hp = B.H + it_ * 4096; const float* Pp = B.PC + it_ * 64; \
        _Pragma("unroll") for (int t = 0; t < 4; ++t) { \
            _Pragma("unroll") for (int ks = 0; ks < 2; ++ks) _Pragma("unroll") for (int hf = 0; hf < 2; ++hf) gfr[t][ks][hf] = *(const u32x2*)(Gp + (t * 16 + vl) * 64 + 16 * (2 * ks + hf) + 4 * q); \
            hfr[t] = *(const u32x2*)(Hp + v * 64 + t * 16 + 4 * q); pc[t] = *(const f32x4*)(Pp + t * 16 + 4 * q); } } while (0)
    RK_LOAD(0);
#pragma unroll 1
    for (int c = 0; c < 64; ++c) {
        u32x2 sb[4];
#pragma unroll
        for (int t = 0; t < 4; ++t) { sb[t].x = cvt_pk_bf16(S[t][0], S[t][1]); sb[t].y = cvt_pk_bf16(S[t][2], S[t][3]); }
        { bf16_t* Sp = B.S0 + (size_t)(bh * 64 + c) * 4096 + v * 64 + 4 * q;
#pragma unroll
          for (int t = 0; t < 4; ++t) *(u32x2*)(Sp + t * 16) = sb[t]; }
        bf16x8 bfr[2];
        { u32x4 w0 = {sb[0].x, sb[0].y, sb[1].x, sb[1].y}, w1 = {sb[2].x, sb[2].y, sb[3].x, sb[3].y}; bfr[0] = *reinterpret_cast<bf16x8*>(&w0); bfr[1] = *reinterpret_cast<bf16x8*>(&w1); }
        f32x4 acc[4];
#pragma unroll
        for (int t = 0; t < 4; ++t) { const f32x4 hv = (f32x4){bflo(hfr[t].x), bfhi(hfr[t].x), bflo(hfr[t].y), bfhi(hfr[t].y)}; acc[t] = S[t] * pc[t] + hv; }
        bf16x8 afr[4][2];
#pragma unroll
        for (int t = 0; t < 4; ++t)
#pragma unroll
            for (int ks = 0; ks < 2; ++ks) { u32x4 w = {gfr[t][ks][0].x, gfr[t][ks][0].y, gfr[t][ks][1].x, gfr[t][ks][1].y}; afr[t][ks] = *reinterpret_cast<bf16x8*>(&w); }
        if (c + 1 < 64) RK_LOAD(c + 1);
#pragma unroll
        for (int t = 0; t < 4; ++t) { acc[t] = __builtin_amdgcn_mfma_f32_16x16x32_bf16(afr[t][0], bfr[0], acc[t], 0, 0, 0); acc[t] = __builtin_amdgcn_mfma_f32_16x16x32_bf16(afr[t][1], bfr[1], acc[t], 0, 0, 0); }
#pragma unroll
        for (int t = 0; t < 4; ++t) S[t] = acc[t];
    }
#undef RK_LOAD
}

__device__ __forceinline__ void out_item(Frame& F, const Bufs& B, int item, int tn) {
    const int lane = F.lane, il = lane & 15, q = lane >> 4;
    const int bh = item >> 6, ch = item & 63, b = bh >> 4, h = bh & 15;
    const size_t tok0 = (size_t)b * SEQ + ch * 64, row = tok0 + tn * 16 + il;
    const bf16_t* Qp = B.Qe + (size_t)item * 4096 + (tn * 16 + il) * 64 + q * 8;
    const bf16_t* Sp = B.S0 + (size_t)item * 4096 + il * 64 + q * 8;
    const bf16x8 b0 = *(const bf16x8*)Qp, b1 = *(const bf16x8*)(Qp + 32);
    const bf16_t* LAr = (const bf16_t*)(F.ws + WS_LA) + row * LAW + 256 + q * 8;
    const bf16_t* Wg = (const bf16_t*)(F.ws + WS_WGATE) + (size_t)(h * 64 + il) * 256 + q * 8;
    bf16x8 gb[8];
#pragma unroll
    for (int ks = 0; ks < 8; ++ks) gb[ks] = *(const bf16x8*)(LAr + ks * 32);
    f32x4 y[4], g[4];
#pragma unroll
    for (int t = 0; t < 4; ++t) {
        const u32x2 yi = *(const u32x2*)(B.Yi + (size_t)item * 4096 + (tn * 16 + il) * 64 + t * 16 + 4 * q);
        f32x4 acc = (f32x4){bflo(yi.x), bfhi(yi.x), bflo(yi.y), bfhi(yi.y)};
        const bf16x8 a0 = *(const bf16x8*)(Sp + t * 16 * 64), a1 = *(const bf16x8*)(Sp + t * 16 * 64 + 32);
        acc = __builtin_amdgcn_mfma_f32_16x16x32_bf16(a0, b0, acc, 0, 0, 0); y[t] = __builtin_amdgcn_mfma_f32_16x16x32_bf16(a1, b1, acc, 0, 0, 0);
        f32x4 ga = (f32x4){0.f, 0.f, 0.f, 0.f};
#pragma unroll
        for (int ks = 0; ks < 8; ++ks) { const bf16x8 wa = *(const bf16x8*)(Wg + (size_t)t * 16 * 256 + ks * 32); ga = __builtin_amdgcn_mfma_f32_16x16x32_bf16(wa, gb[ks], ga, 0, 0, 0); }
        g[t] = ga;
    }
    float s = 0.f;
#pragma unroll
    for (int t = 0; t < 4; ++t) s += (y[t][0] + y[t][1]) + (y[t][2] + y[t][3]);
    s += __shfl_xor(s, 16); s += __shfl_xor(s, 32);
    const float mean = s * (1.f / 64.f); float d2 = 0.f;
#pragma unroll
    for (int t = 0; t < 4; ++t)
#pragma unroll
        for (int e = 0; e < 4; ++e) { const float d = y[t][e] - mean; d2 += d * d; }
    d2 += __shfl_xor(d2, 16); d2 += __shfl_xor(d2, 32);
    const float rstd = rsqrtf(d2 * (1.f / 64.f) + GN_EPS);
    const float bon = B.BON[row * RH + h];
    const bf16_t* pr = (const bf16_t*)(F.ws + WS_P) + row * IN_COLS + C_V + h * 64; const bool hp = (ch * 64 + tn * 16 + il) > 0;
    bf16_t* Yo = (bf16_t*)(F.ws + WS_YCAT) + row * DM + h * 64;
#pragma unroll
    for (int t = 0; t < 4; ++t) {
        const int c0 = t * 16 + 4 * q; const u32x2 cv = *(const u32x2*)(pr + c0); u32x2 qv = (u32x2){0u, 0u}; if (hp) qv = *(const u32x2*)(pr - IN_COLS + c0);
        const f32x4 mu = *(const f32x4*)(F.in[I_MU] + C_V + h * 64 + c0), lg = *(const f32x4*)(F.in[I_LNG] + h * 64 + c0), lb = *(const f32x4*)(F.in[I_LNB] + h * 64 + c0);
        f32x4 vv = (f32x4){bflo(cv.x), bfhi(cv.x), bflo(cv.y), bfhi(cv.y)}; const f32x4 pv = (f32x4){bflo(qv.x), bfhi(qv.x), bflo(qv.y), bfhi(qv.y)};
        vv = vv + (pv - vv) * mu;
        f32x4 o;
#pragma unroll
        for (int e = 0; e < 4; ++e) o[e] = ((y[t][e] - mean) * rstd * lg[e] + lb[e] + bon * vv[e]) * g[t][e];
        u32x2 w; w.x = cvt_pk_bf16(o[0], o[1]); w.y = cvt_pk_bf16(o[2], o[3]);
        *(u32x2*)(Yo + c0) = w;
    }
}
}
constexpr int N_PHASES = 14;
struct Args { const void* in[30]; float* out; unsigned char* ws; int ph_lo, ph_hi, li, pad; };
__global__ void __launch_bounds__(NWAVES * 64, 2) mk_fwd(Args args) {
    extern __shared__ __attribute__((aligned(16))) unsigned char lds[];
    Frame F;
    F.lds = (LAS unsigned char*)lds;
    F.MISC = (volatile LAS unsigned*)(F.lds + MISC_OFF);
    F.tid = threadIdx.x; F.lane = F.tid & 63; F.wave = __builtin_amdgcn_readfirstlane(F.tid >> 6);
    F.G = gridDim.x; { const int bx = blockIdx.x; F.vcu = (F.G % 8 == 0) ? (bx % 8) * (F.G / 8) + bx / 8 : bx; }
    F.ws = args.ws; F.out = args.out; F.ctl = (gu32*)(args.ws + WS_CTL);
#pragma unroll
    for (int i = 0; i < 30; ++i) F.in[i] = (const float*)args.in[i];
    for (int u = F.tid; u < (LDS_BYTES - LDSCTL_OFF) / 4; u += NWAVES * 64) ((LAS unsigned*)(F.lds + LDSCTL_OFF))[u] = 0u;
    __syncthreads();
    XcdBarrier bar; bar.bar = (unsigned*)(F.ctl + CW_BAR); bar.x = 0; bar.st = nullptr;
#if MK_ONE_LAUNCH
    bar = xcd_barrier_post((unsigned*)(F.ctl + CW_BAR), F.MISC + 8);
#define GRID_BAR() xcd_barrier(bar)
#else
#define GRID_BAR() do { } while (0)
#endif
    const int lo = args.ph_lo, hi = args.ph_hi;
#ifndef P4SEL
#define P4SEL 31
#endif
#ifndef MK_FLIP
#define MK_FLIP 0
#endif
#ifndef PH_MASK
#define PH_MASK 0x3fff
#endif
#define IN(k) (((PH_MASK >> (k)) & 1) && lo <= (k) && (k) < hi)
#define SEAM(k) do { if (IN(k) && IN((k) + 1)) GRID_BAR(); } while (0)
    float* LD = args.out; bf16_t* Ab = (bf16_t*)((char*)args.out + 64 * MiB); bf16_t* Gb = (bf16_t*)((char*)args.out + 96 * MiB);

    if (IN(0)) { phase_mod(F); SEAM(0); }
    if (IN(1)) { phase_weights(F); phase_convcopy(F); phase_hprep(F); SEAM(1); }
    if (IN(2)) {
        pg8::Gemm g{(const bf16_t*)(F.ws + WS_H), (const bf16_t*)(F.ws + WS_WIN), TOK, IN_COLS, DM, DM, DM};
        pg8::StaticOrder S; S.init(TOK, IN_COLS, F.G, (int)blockIdx.x);
        EpiOut<0> E{(bf16_t*)(F.ws + WS_P), nullptr, IN_COLS, nullptr, 1.f, nullptr, nullptr};
        pg8::gemm_phase(F.lds + RING_OFF, g, S, E);
        SEAM(2);
    }
    if (IN(3)) { phase_tokprep(F); SEAM(3); }
    if (IN(4)) {
#pragma unroll 1
        for (int gi = 0; gi < 2; ++gi) {
            pg8::Gemm g; EpiMulti E;
            const bf16_t* Pb = (const bf16_t*)(F.ws + WS_P);
            if (gi == 0)      { g = pg8::Gemm{Pb + C_QL, (const bf16_t*)(F.ws + WS_WQ), TOK, QW, QLR, IN_COLS, QLR};
                                E = EpiMulti{1, (bf16_t*)(F.ws + WS_Q), nullptr, QW, (const float*)(F.ws + WS_RSTDQ), 0.07216878364870322f * 1.4426950408889634f, nullptr}; }
            else              { g = pg8::Gemm{Pb + C_KVL, (const bf16_t*)(F.ws + WS_WKV), TOK, KVW, KVLR, IN_COLS, KVLR};
                                E = EpiMulti{1, (bf16_t*)(F.ws + WS_KV), nullptr, KVW, (const float*)(F.ws + WS_RSTDKV), 1.f, nullptr}; }
            pg8::StaticOrder S; S.init(g.M, g.N, F.G, (int)blockIdx.x);
            pg8::gemm_phase(F.lds + RING_OFF, g, S, E);
        }
        SEAM(4);
    }
    rk::Bufs RB{(bf16_t*)args.out, (bf16_t*)((char*)args.out + 32 * MiB), (bf16_t*)((char*)args.out + 64 * MiB), (bf16_t*)((char*)args.out + 96 * MiB),
                (bf16_t*)(F.ws + WS_H + 16 * MiB), (float*)(F.ws + WS_H + 48 * MiB), (float*)(F.ws + WS_H + 49 * MiB)};
    if (IN(5)) {
#pragma unroll 1
        for (int it = 0;; ++it) { const int item = (it & 15) + 16 * (F.vcu + (it >> 4) * F.G); if (item >= 4096) break; rk::prep_item(F, RB, item); }
        SEAM(5);
    }
    if (IN(6)) {
        if (F.wave == 0) for (int u = F.vcu; u < 256; u += F.G) rk::scan_unit(RB, u >> 2, u & 3, F.lane);
        SEAM(6);
    }
    if (IN(7)) {
        for (int task = F.vcu * NWAVES + F.wave; task < 16384; task += F.G * NWAVES) rk::out_item(F, RB, task >> 2, task & 3);
        __syncthreads();
        for (int u = F.vcu; u < 256; u += F.G) {
            const int bh = u >> 3, s = u & 7, b = bh >> 3, h = bh & 7;
#pragma unroll 1
            for (int it2 = 0; it2 < 2; ++it2)
                att::attn_unit(b, h, it2 ? 15 - s : s, (const bf16_t*)(F.ws + WS_Q), (const bf16_t*)(F.ws + WS_KV), (const bf16_t*)(F.ws + WS_KR), (const f32x2*)(F.ws + WS_CS), (bf16_t*)(F.ws + WS_YCAT), (char*)lds);
        }
        SEAM(7);
    }
    if (IN(8)) {
        pg8::Gemm g{(const bf16_t*)(F.ws + WS_YCAT), (const bf16_t*)(F.ws + WS_WOUT), TOK, DM, DM, DM, DM};
        pg8::StaticOrder S; S.init(TOK, DM, F.G, (int)blockIdx.x);
        EpiOut<4> E{(bf16_t*)(F.ws + WS_O1), nullptr, DM, nullptr, 1.f, nullptr, (float*)(F.ws + WS_SSQ1)};
        pg8::gemm_phase(F.lds + RING_OFF, g, S, E);
        SEAM(8);
    }
    if (IN(9)) { phase_mid(F); SEAM(9); }
    if (IN(10)) {
        pg8::Gemm g{(const bf16_t*)(F.ws + WS_H), (const bf16_t*)(F.ws + WS_WUP), TOK, UPW, DM, DM, DM};
        pg8::StaticOrder S; S.init(TOK, UPW, F.G, (int)blockIdx.x); S.flip = MK_FLIP;
        EpiConv E{(bf16_t*)(F.ws + WS_ACT), (const float*)(F.ws + WS_CONV), (const float*)(F.ws + WS_CONV) + 3 * UPW, (float*)(F.ws + WS_HEAD), (float*)(F.ws + WS_TAIL), (LAS float*)(F.lds + TB_OFF)};
        pg8::gemm_phase(F.lds + RING_OFF, g, S, E);
        SEAM(10);
    }
    if (IN(11)) { phase_fixup(F); SEAM(11); }
    if (IN(12)) {
        pg8::Gemm g{(const bf16_t*)(F.ws + WS_ACT), (const bf16_t*)(F.ws + WS_WDOWN), TOK, DM, DFF, DFF, DFF};
        pg8::StaticOrder S; S.init(TOK, DM, F.G, (int)blockIdx.x);
        EpiOut<4> E{(bf16_t*)(F.ws + WS_O2), nullptr, DM, nullptr, 1.f, nullptr, (float*)(F.ws + WS_SSQ2)};
        pg8::gemm_phase(F.lds + RING_OFF, g, S, E);
        SEAM(12);
    }
    if (IN(13)) { phase_final(F); }
#undef IN
#undef SEAM
}

#if MK_CHECK
#ifndef MK_RPT
#define MK_RPT 0
#endif
__global__ void chk_scan(const bf16_t* p, size_t n, unsigned* flag) {
    float mx = 0.f; bool nf = false;
    for (size_t i = blockIdx.x * 256 + threadIdx.x; i < n; i += (size_t)gridDim.x * 256) { const float v = bf2f(p[i]); if (!(fabsf(v) <= 3e38f)) nf = true; else mx = fmaxf(mx, fabsf(v)); }
    if (nf) atomicOr(flag, 1u);
    atomicMax(flag + 1, __float_as_uint(mx));
}
__global__ void chk_apply(Args a) {
    unsigned* fl = (unsigned*)(a.ws + WS_CTL) + 8;
    for (size_t i = blockIdx.x * 256 + threadIdx.x; i < (size_t)TOK * DM; i += (size_t)gridDim.x * 256) a.out[i] = 0.f;
    __syncthreads();
    if (blockIdx.x == 0 && threadIdx.x == 0) {
        const unsigned s = MK_RPT; const bool nf = fl[2 * s] != 0u; const float mx = __uint_as_float(fl[2 * s + 1]);
        int dg = (int)floorf(log10f(fmaxf(mx, 1e-30f))) + 5; if (dg < 0) dg = 0; if (dg > 9) dg = 9;
        a.out[1] = 1000.f * (float)(10 * (nf ? 9 : 1) + dg);
    }
}
#endif
#if MK_CHECK
__global__ void __launch_bounds__(64) chk_rwkv(Args a, int b, int h, int NTOK) {
    __shared__ float vec[5][64];
    const float* const* in = (const float* const*)a.in; unsigned char* ws = a.ws; unsigned* fl = (unsigned*)(ws + WS_CTL) + 8 + 60;
    const bf16_t* P = (const bf16_t*)(ws + WS_P); const bf16_t* Y = (const bf16_t*)(ws + WS_YCAT);
    const int lane = threadIdx.x, col = h * 64 + lane;
    float S[64];
#pragma unroll
    for (int k = 0; k < 64; ++k) S[k] = 0.f;
    float maxrel = 0.f; int first = 999;
    for (int t = 0; t < NTOK; ++t) {
        const size_t row = (size_t)b * SEQ + t; const bf16_t* pr = P + row * IN_COLS; const bf16_t* pp = pr - IN_COLS; const bool hp = t > 0;
        float r = bf2f(pr[C_R + col]), k = bf2f(pr[C_K + col]), v = bf2f(pr[C_V + col]);
        r += ((hp ? bf2f(pp[C_R + col]) : 0.f) - r) * in[I_MU][C_R + col]; k += ((hp ? bf2f(pp[C_K + col]) : 0.f) - k) * in[I_MU][C_K + col]; v += ((hp ? bf2f(pp[C_V + col]) : 0.f) - v) * in[I_MU][C_V + col];
        float sw = 0.f, sa = 0.f, sg = 0.f;
        for (int l = 0; l < 96; ++l) { float x = bf2f(pr[C_WD + l]); x += ((hp ? bf2f(pp[C_WD + l]) : 0.f) - x) * in[I_MU][C_WD + l]; sw += tanhf(x) * in[I_WDEC][(size_t)l * RW + col];
                                       float x2 = bf2f(pr[C_AD + l]); x2 += ((hp ? bf2f(pp[C_AD + l]) : 0.f) - x2) * in[I_MU][C_AD + l]; sa += x2 * in[I_WICLR][(size_t)l * RW + col]; }
        for (int l = 0; l < 256; ++l) { float x = bf2f(pr[C_GD + l]); x += ((hp ? bf2f(pp[C_GD + l]) : 0.f) - x) * in[I_MU][C_GD + l]; sg += 1.f / (1.f + expf(-x)) * in[I_WGATE][(size_t)l * RW + col]; }
        const float z = in[I_W0][col] + sw; const float w = expf(-expf(-log1pf(expf(-z)) - 0.5f)); const float aa = 1.f / (1.f + expf(-(in[I_A0][col] + sa)));
        float kkx = k * in[I_KK][col]; float ss = kkx * kkx;
        for (int o = 1; o < 64; o <<= 1) ss += __shfl_xor(ss, o);
        const float kk = kkx / fmaxf(sqrtf(ss), 1e-12f); const float km = k * (1.f + (aa - 1.f) * in[I_KA][col]);
        float bon = r * km * in[I_RK][col];
        for (int o = 1; o < 64; o <<= 1) bon += __shfl_xor(bon, o);
        __syncthreads();
        vec[0][lane] = r; vec[1][lane] = w; vec[2][lane] = km; vec[3][lane] = -kk; vec[4][lane] = MK_NODELTA ? 0.f : kk * aa;
        __syncthreads();
        float sac = 0.f;
#pragma unroll
        for (int kq = 0; kq < 64; ++kq) sac += S[kq] * vec[3][kq];
        if (t < 64) { const bf16_t* dbgb = (const bf16_t*)(ws + WS_CTL + 32768); const float got = bf2f(dbgb[lane * 64 + t]); float e2 = (got - sac) * (got - sac), s2 = sac * sac;
            for (int o = 1; o < 64; o <<= 1) { e2 += __shfl_xor(e2, o); s2 += __shfl_xor(s2, o); }
            const float re = sqrtf(e2 / fmaxf(s2, 1e-20f)); if (lane == 0) { float* ff = (float*)fl; if (re > ff[10]) { ff[10] = re; fl[11] = (unsigned)t; } if (t == 1) ff[12] = re; if (t == 8) ff[13] = re; if (t == 40) ff[14] = re; } }
        float y = 0.f;
#pragma unroll
        for (int kq = 0; kq < 64; ++kq) { S[kq] = S[kq] * vec[1][kq] + sac * vec[4][kq] + v * vec[2][kq]; y += S[kq] * vec[0][kq]; }
        float mean = y; for (int o = 1; o < 64; o <<= 1) mean += __shfl_xor(mean, o); mean *= (1.f / 64.f);
        float var = (y - mean) * (y - mean); for (int o = 1; o < 64; o <<= 1) var += __shfl_xor(var, o); var *= (1.f / 64.f);
        const float ref = ((y - mean) * rsqrtf(var + GN_EPS) * in[I_LNG][col] + in[I_LNB][col] + bon * v) * sg;
        const float got = bf2f(Y[row * DM + col]);
        float err = fabsf(got - ref); float sc = fabsf(ref); for (int o = 1; o < 64; o <<= 1) { err = fmaxf(err, __shfl_xor(err, o)); sc = fmaxf(sc, __shfl_xor(sc, o)); }
        const float rel = err / fmaxf(sc, 1e-6f);
        if ((t & 63) == 63 && t < 64 * 4) {
            const bf16_t* S0b = (const bf16_t*)(ws + WS_H + 16 * MiB) + ((size_t)((b * 16 + h) * 64 + (t >> 6) + 1)) * 4096 + lane * 64;
            float e2 = 0.f, s2 = 0.f;
            for (int kq = 0; kq < 64; ++kq) { const float d = bf2f(S0b[kq]) - S[kq]; e2 += d * d; s2 += S[kq] * S[kq]; }
            for (int o = 1; o < 64; o <<= 1) { e2 += __shfl_xor(e2, o); s2 += __shfl_xor(s2, o); }
            if (lane == 0) ((float*)fl)[2 + (t >> 6)] = sqrtf(e2 / fmaxf(s2, 1e-20f));
        }
        if (rel > 0.06f && first == 999) first = t;
        maxrel = fmaxf(maxrel, rel);
    }
    if (lane == 0) { fl[0] = (unsigned)first; ((float*)fl)[1] = maxrel; }
}
__global__ void chk_apply2(Args a) {
    const unsigned* fl = (const unsigned*)(a.ws + WS_CTL) + 8 + 60;
    for (size_t i = blockIdx.x * 256 + threadIdx.x; i < (size_t)TOK * DM; i += (size_t)gridDim.x * 256) a.out[i] = 0.f;
    __syncthreads();
    if (blockIdx.x == 0 && threadIdx.x == 0) {
        const unsigned first = fl[0]; const float mr = ((const float*)fl)[1];
        if (MK_RPT == 121) { a.out[1] = 1000.f * (float)fl[11]; return; }
        if (MK_RPT >= 120) { a.out[1] = 1000.f * fminf(99.f, rintf(((const float*)fl)[10 + (MK_RPT == 120 ? 0 : MK_RPT - 120)] * 100.f)); return; }
        if (MK_RPT >= 110) { a.out[1] = 1000.f * fminf(99.f, rintf(((const float*)fl)[2 + MK_RPT - 110] * 100.f)); return; }
        unsigned code = MK_RPT == 100 ? (first > 4095u ? 99u : first / 64u) : MK_RPT == 102 ? (first > 4095u ? 99u : first % 64u) : (unsigned)fminf(99.f, mr * 100.f);
        a.out[1] = 1000.f * (float)code;
    }
}
#endif
extern "C" void kernel_launch(void* const* d_in, const int* in_sizes, int n_in, void* d_out, int out_size, void* d_ws, size_t ws_size, hipStream_t stream) {
    static int grid = 0;
    if (grid == 0) {
        if (n_in != 30 || in_sizes[0] != TOK * DM || out_size != TOK * DM || ws_size < WS_END) {
            fprintf(stderr, "kernel_launch: unexpected shapes: n_in %d in0 %d out %d ws %zu (need %zu)\n", n_in, n_in > 0 ? in_sizes[0] : -1, out_size, ws_size, (size_t)WS_END); grid = -1; return; }
        int dev = 0, cus = 0, per_cu = 0;
        if (hipGetDevice(&dev) != hipSuccess || hipDeviceGetAttribute(&cus, hipDeviceAttributeMultiprocessorCount, dev) != hipSuccess) { fprintf(stderr, "kernel_launch: device query failed\n"); grid = -1; return; }
        if (hipFuncSetAttribute((const void*)mk_fwd, hipFuncAttributeMaxDynamicSharedMemorySize, LDS_BYTES) != hipSuccess) { fprintf(stderr, "kernel_launch: hipFuncSetAttribute failed\n"); grid = -1; return; }
        if (hipOccupancyMaxActiveBlocksPerMultiprocessor(&per_cu, (const void*)mk_fwd, NWAVES * 64, LDS_BYTES) != hipSuccess || per_cu < 1) {
            fprintf(stderr, "kernel_launch: occupancy query reports %d blocks per CU\n", per_cu); grid = -1; (void)hipGetLastError(); return; }
        (void)hipGetLastError();
        grid = cus;
    }
    if (grid < 0) return;
    if (hipMemsetAsync((char*)d_ws + WS_CTL, 0, CTL_ZERO_BYTES, stream) != hipSuccess) { fprintf(stderr, "kernel_launch: memset failed\n"); return; }
    Args a{};
    for (int i = 0; i < 30; ++i) a.in[i] = d_in[i];
    a.out = (float*)d_out; a.ws = (unsigned char*)d_ws;
#if MK_ONE_LAUNCH
    a.ph_lo = 0; a.ph_hi = N_PHASES; a.li = 0;
    hipLaunchKernelGGL(mk_fwd, dim3(grid), dim3(NWAVES * 64), LDS_BYTES, stream, a);
#else
    for (int p = 0; p < N_PHASES; ++p) { a.ph_lo = p; a.ph_hi = p + 1; a.li = 0; hipLaunchKernelGGL(mk_fwd, dim3(grid), dim3(NWAVES * 64), LDS_BYTES, stream, a);
#if MK_CHECK
        { unsigned* fl = (unsigned*)((char*)d_ws + WS_CTL) + 8; const size_t NI = (size_t)4096 * 4096;
          if (p == 5) { hipLaunchKernelGGL(chk_scan, dim3(1024), dim3(256), 0, stream, (const bf16_t*)d_out, NI, fl + 0); hipLaunchKernelGGL(chk_scan, dim3(1024), dim3(256), 0, stream, (const bf16_t*)((char*)d_out + 32 * MiB), NI, fl + 2);
                        hipLaunchKernelGGL(chk_scan, dim3(1024), dim3(256), 0, stream, (const bf16_t*)((char*)d_out + 64 * MiB), NI, fl + 4); hipLaunchKernelGGL(chk_scan, dim3(1024), dim3(256), 0, stream, (const bf16_t*)((char*)d_out + 96 * MiB), NI, fl + 6); }
          if (p == 6) hipLaunchKernelGGL(chk_scan, dim3(1024), dim3(256), 0, stream, (const bf16_t*)((char*)d_ws + WS_H + 16 * MiB), NI, fl + 8);
          if (p == 7 && MK_RPT >= 100) hipLaunchKernelGGL(chk_rwkv, dim3(1), dim3(64), 0, stream, a, 3, 15, 4096);
          if (p == 7) hipLaunchKernelGGL(chk_scan, dim3(1024), dim3(256), 0, stream, (const bf16_t*)((char*)d_ws + WS_YCAT), (size_t)TOK * DM, fl + 10); }
#endif
    }
#if MK_CHECK
    if (MK_RPT >= 100) hipLaunchKernelGGL(chk_apply2, dim3(1024), dim3(256), 0, stream, a); else hipLaunchKernelGGL(chk_apply, dim3(1024), dim3(256), 0, stream, a);
#endif
#endif
    const hipError_t le = hipPeekAtLastError();
    if (le != hipSuccess) fprintf(stderr, "kernel_launch: launch failed: %s\n", hipGetErrorName(le));
}
```

```cpp
#include <hip/hip_runtime.h>
#include <cstdio>
#include <cstdint>

#ifndef MK_CHECK
#define MK_CHECK 0
#endif
#ifndef MK_RPT
#define MK_RPT 0
#endif
#ifndef MK_NODELTA
#define MK_NODELTA 0
#endif
#ifndef MK_R2SKIP
#define MK_R2SKIP 0
#endif
#ifndef MK_ONE_LAUNCH
#define MK_ONE_LAUNCH 1
#endif

constexpr int DM = 2048, NB = 4, SEQ = 4096, TOK = NB * SEQ;
constexpr int RW = 1024, RH = 16, RN = 64;
constexpr int IN_COLS = 4352;
constexpr int C_R = 0, C_K = 1024, C_V = 2048, C_WD = 3072, C_AD = 3168, C_GD = 3264, C_QL = 3520, C_KVL = 4032, C_KR = 4288;
constexpr int QLR = 512, KVLR = 256, MH = 8, DN = 128, DR = 64, DV = 128, QHD = 192;
constexpr int QW = MH * QHD, KVW = MH * (DN + DV);
constexpr int DFF = 5632, UPW = 2 * DFF;
constexpr float NORM_EPS = 1e-6f, GN_EPS = 64e-5f;
constexpr int LAW = 512;

constexpr size_t MiB = 1u << 20;
constexpr size_t WS_CTL = 0, CTL_ZERO_BYTES = 64 * 1024;
constexpr size_t WS_MODP = 1 * MiB;
constexpr size_t WS_RSTDQ = 1 * MiB + 800 * 1024;
constexpr size_t WS_RSTDKV = WS_RSTDQ + 64 * 1024;
constexpr size_t WS_SSQ1 = 2 * MiB, WS_SSQ2 = 4 * MiB;
constexpr size_t WS_HEAD = 6 * MiB, WS_TAIL = 12 * MiB;
constexpr size_t WS_WIN = 18 * MiB, WS_WQ = 35 * MiB, WS_WKV = 37 * MiB, WS_WOUT = 38 * MiB, WS_WUP = 46 * MiB, WS_WDOWN = 90 * MiB;
constexpr size_t WS_WDEC = 112 * MiB, WS_WICLR = WS_WDEC + 256 * 1024, WS_WGATE = WS_WICLR + 256 * 1024;
constexpr size_t WS_CONV = WS_WGATE + 512 * 1024;
constexpr size_t WS_H = 114 * MiB;
constexpr size_t WS_LA = WS_H;
constexpr size_t WS_P = 178 * MiB;
constexpr size_t WS_Q = 314 * MiB;
constexpr size_t WS_KV = 362 * MiB;
constexpr size_t WS_KR = 426 * MiB;
constexpr size_t WS_CS = 428 * MiB;
constexpr size_t WS_YCAT = 432 * MiB;
constexpr size_t WS_END = 496 * MiB;
constexpr size_t WS_O1 = WS_Q;
constexpr size_t WS_ACT = 250 * MiB;
constexpr size_t WS_O2 = WS_YCAT;
constexpr size_t WS_X2 = WS_P;
static_assert(WS_ACT + (size_t)TOK * DFF * 2 <= WS_KR && WS_X2 + (size_t)TOK * DM * 2 <= WS_ACT, "act / x2 overlays");

#define GAS __attribute__((address_space(1)))
#define LAS __attribute__((address_space(3)))
typedef unsigned short bf16_t;
typedef short bf16x8 __attribute__((ext_vector_type(8)));
typedef float f32x4 __attribute__((ext_vector_type(4)));
typedef float f32x2 __attribute__((ext_vector_type(2)));
typedef float f32x16 __attribute__((ext_vector_type(16)));
typedef unsigned u32x4 __attribute__((ext_vector_type(4)));
typedef unsigned u32x2 __attribute__((ext_vector_type(2)));
typedef short s16x4 __attribute__((ext_vector_type(4)));
typedef GAS unsigned gu32;

typedef __bf16 bf16x2_t __attribute__((ext_vector_type(2)));
__device__ __forceinline__ unsigned cvt_pk_bf16(float lo, float hi) { const f32x2 v = {lo, hi}; const bf16x2_t b = __builtin_convertvector(v, bf16x2_t); return __builtin_bit_cast(unsigned, b); }
__device__ __forceinline__ unsigned cvt_pk_bf16_asm(float lo, float hi) { unsigned r; asm volatile("v_cvt_pk_bf16_f32 %0, %1, %2" : "=v"(r) : "v"(lo), "v"(hi)); return r; }
__device__ __forceinline__ float bf2f(unsigned short u) { return __uint_as_float((unsigned)u << 16); }
__device__ __forceinline__ float bflo(unsigned w) { return __uint_as_float(w << 16); }
__device__ __forceinline__ float bfhi(unsigned w) { return __uint_as_float(w & 0xffff0000u); }
__device__ __forceinline__ unsigned short f2bf(float f) { return (unsigned short)(cvt_pk_bf16(f, f) & 0xffffu); }
__device__ __forceinline__ float wave_sum(float v) {
#pragma unroll
    for (int o = 1; o < 64; o <<= 1) v += __shfl_xor(v, o);
    return v;
}
__device__ __forceinline__ float fast_exp(float x) { return __builtin_amdgcn_exp2f(x * 1.4426950408889634f); }
__device__ __forceinline__ float fast_sigmoid(float x) { return __builtin_amdgcn_rcpf(1.f + fast_exp(-x)); }
__device__ __forceinline__ float fast_tanh(float x) { return 1.f - 2.f * __builtin_amdgcn_rcpf(1.f + fast_exp(2.f * x)); }
namespace pg8 {
constexpr int BM = 256, BK = 64, HALF = 128, HTB = HALF * BK * 2, STAGE_BYTES = 8 * HTB, NXCD = 8, WGM = 8;
__host__ __device__ __forceinline__ int lds_byte(int r, int c) { const int st = (r >> 4) * 2 + (c >> 5), rr = r & 15, cc = c & 31, ob = rr * 64 + cc * 2; return st * 1024 + (ob ^ (((ob >> 9) & 1) << 5)); }
__host__ __device__ __forceinline__ void stage_rc(int b, int& R, int& C) { const int st = b / 1024, sb = b % 1024, swz = sb ^ (((sb >> 9) & 1) << 5); R = (st >> 1) * 16 + swz / 64; C = (st & 1) * 32 + (swz % 64) / 2; }
__host__ __device__ __forceinline__ int perm32(int rho) { const int n = rho >> 4, i = rho & 15; return 8 * (i >> 2) + 4 * n + (i & 3); }

struct Unit { int pm, pn; };
struct Gemm { const bf16_t* A; const bf16_t* Bt; int M, N, K, lda, ldb; };

struct StaticOrder {
    int nM, nN, nwg, G, c, flip = 0;
    __host__ __device__ void init(int M, int N, int G_, int c_) { nM = M / BM; nN = N / BM; nwg = nM * nN; G = G_; c = c_; }
    __host__ __device__ bool next(int i, Unit& u) const {
        const long L = (long)i * G + c; if (L >= nwg) return false;
        int wgid = (int)L; { const int q = nwg / NXCD, r = nwg % NXCD, xcd = wgid % NXCD, off = wgid / NXCD; wgid = (xcd < r ? xcd * (q + 1) : r * (q + 1) + (xcd - r) * q) + off; }
        const int nig = WGM * nN, gid = wgid / nig, fm = gid * WGM, gsz = (nM - fm) < WGM ? (nM - fm) : WGM;
        u.pm = fm + ((wgid % nig) % gsz); u.pn = (wgid % nig) / gsz; if (flip) u.pn = nN - 1 - u.pn; return true;
    }
};


template <class Epi, class Sched>
__device__ __forceinline__ void gemm_phase(LAS unsigned char* lds, const Gemm g, const Sched& S, const Epi& E) {
    const int tid = threadIdx.x, wid = __builtin_amdgcn_readfirstlane(tid >> 6), lane = tid & 63, wr = wid >> 2, wc = wid & 3, fr = lane & 15, fq = lane >> 4;
    const int K = g.K, nt = K / BK;
    unsigned voffA[2], voffB[2];
#pragma unroll
    for (int i = 0; i < 2; ++i) { int R, C; stage_rc(tid * 16 + i * 8192, R, C); const int Rb = (R & ~31) + perm32(R & 31);
        voffA[i] = (unsigned)(R * g.lda + C) * 2u; voffB[i] = (unsigned)(Rb * g.ldb + C) * 2u; }
    const size_t kstep = (size_t)(BK * 2);
    const size_t hstepA = (size_t)HALF * g.lda * 2, hstepB = (size_t)HALF * g.ldb * 2;
    const size_t tstepA = 2 * hstepA, tstepB = 2 * hstepB;
    const unsigned ldsw = (unsigned)wid * 1024u;
    const int aoff = lds_byte(wr * 64 + fr, fq * 8), boff = lds_byte(wc * 32 + fr, fq * 8);
#define PG8_SA(b, h) (((b) * 2 + (h)) * HTB)
#define PG8_SB(b, h) ((4 + (b) * 2 + (h)) * HTB)
#define PG8_STAGE(bufoff, gbase, voff) do { _Pragma("unroll") for (int _i = 0; _i < 2; ++_i) \
        __builtin_amdgcn_global_load_lds((const unsigned*)((const char*)(gbase) + (voff)[_i]), (LAS unsigned*)(lds + (bufoff) + ldsw + _i * 8192), 16, 0, 0); } while (0)
#define PG8_LDA(dst, b, h) do { _Pragma("unroll") for (int m = 0; m < 4; ++m) _Pragma("unroll") for (int k = 0; k < 2; ++k) dst[m][k] = *(const LAS bf16x8*)(lds + PG8_SA(b, h) + aoff + m * 2048 + k * 1024); } while (0)
#define PG8_LDB(dst, b, h) do { _Pragma("unroll") for (int n = 0; n < 2; ++n) _Pragma("unroll") for (int k = 0; k < 2; ++k) dst[n][k] = *(const LAS bf16x8*)(lds + PG8_SB(b, h) + boff + n * 2048 + k * 1024); } while (0)
#define PG8_MMA(ai, bj, At, Bt) do { __builtin_amdgcn_s_setprio(1); _Pragma("unroll") for (int m = 0; m < 4; ++m) _Pragma("unroll") for (int n = 0; n < 2; ++n) _Pragma("unroll") for (int k = 0; k < 2; ++k) \
        acc[ai][bj][m][n] = __builtin_amdgcn_mfma_f32_16x16x32_bf16(Bt[n][k], At[m][k], acc[ai][bj][m][n], 0, 0, 0); __builtin_amdgcn_s_setprio(0); } while (0)
#define PG8_WAIT_V(n) asm volatile("s_waitcnt vmcnt(" #n ")" ::: "memory")
#define PG8_WAIT_L(n) asm volatile("s_waitcnt lgkmcnt(" #n ")" ::: "memory")
#define PG8_BAR __builtin_amdgcn_s_barrier()
#define PG8_SCHED __builtin_amdgcn_sched_barrier(0)
    Unit cur, nxt; int ui = 0;
    if (!S.next(0, cur)) return;
    f32x4 acc[2][2][4][2];
#pragma unroll
    for (int a = 0; a < 2; ++a)
#pragma unroll
        for (int b = 0; b < 2; ++b)
#pragma unroll
            for (int m = 0; m < 4; ++m)
#pragma unroll
                for (int n = 0; n < 2; ++n) acc[a][b][m][n] = (f32x4){0.f, 0.f, 0.f, 0.f};
    bf16x8 At[4][2], B0[2][2], B1[2][2];
    const char* cA = (const char*)g.A + (size_t)cur.pm * tstepA; const char* cB = (const char*)g.Bt + (size_t)cur.pn * tstepB;
    PG8_STAGE(PG8_SB(0, 0), cB, voffB); PG8_STAGE(PG8_SB(0, 1), cB + hstepB, voffB); PG8_STAGE(PG8_SA(0, 0), cA, voffA); PG8_STAGE(PG8_SA(0, 1), cA + hstepA, voffA);
    if (wr == 1) PG8_BAR;
    PG8_WAIT_V(2); PG8_BAR;
    PG8_STAGE(PG8_SB(1, 0), cB + kstep, voffB); PG8_STAGE(PG8_SA(1, 0), cA + kstep, voffA); PG8_STAGE(PG8_SB(1, 1), cB + hstepB + kstep, voffB);
    PG8_WAIT_V(6); PG8_BAR;
    for (;;) {
        const bool has_next = S.next(ui + 1, nxt);
        const char* nA = has_next ? (const char*)g.A + (size_t)nxt.pm * tstepA : cA; const char* nB = has_next ? (const char*)g.Bt + (size_t)nxt.pn * tstepB : cB;
        for (int t = 0; t < nt; t += 2) {
            const bool last = (t == nt - 2);
            const char* a1 = cA + (size_t)(t + 1) * kstep;
            const char* a2 = last ? nA : cA + (size_t)(t + 2) * kstep; const char* b2 = last ? nB : cB + (size_t)(t + 2) * kstep;
            const char* a3 = a2 + kstep; const char* b3 = b2 + kstep;
            PG8_LDB(B0, 0, 0); PG8_LDB(B1, 0, 1); PG8_SCHED; PG8_LDA(At, 0, 0); PG8_STAGE(PG8_SA(1, 1), a1 + hstepA, voffA);
            PG8_WAIT_V(8); PG8_WAIT_L(0); PG8_BAR; PG8_MMA(0, 0, At, B0); PG8_MMA(0, 1, At, B1); PG8_BAR; PG8_SCHED;
            PG8_LDA(At, 0, 1); PG8_STAGE(PG8_SB(0, 0), b2, voffB); PG8_STAGE(PG8_SB(0, 1), b2 + hstepB, voffB); PG8_STAGE(PG8_SA(0, 0), a2, voffA);
            PG8_WAIT_V(8); PG8_WAIT_L(0); PG8_BAR; PG8_MMA(1, 0, At, B0); PG8_MMA(1, 1, At, B1); PG8_BAR; PG8_SCHED;
            PG8_LDB(B0, 1, 0); PG8_LDB(B1, 1, 1); PG8_SCHED; PG8_LDA(At, 1, 0); PG8_STAGE(PG8_SA(0, 1), a2 + hstepA, voffA);
            PG8_WAIT_V(8); PG8_WAIT_L(0); PG8_BAR; PG8_MMA(0, 0, At, B0); PG8_MMA(0, 1, At, B1); PG8_BAR; PG8_SCHED;
            PG8_LDA(At, 1, 1); PG8_STAGE(PG8_SB(1, 0), b3, voffB); PG8_STAGE(PG8_SB(1, 1), b3 + hstepB, voffB); PG8_STAGE(PG8_SA(1, 0), a3, voffA);
            PG8_WAIT_V(8); PG8_WAIT_L(0); PG8_BAR; PG8_MMA(1, 0, At, B0); PG8_MMA(1, 1, At, B1); PG8_BAR; PG8_SCHED;
        }
        if (wr == 0) PG8_BAR;
        E(acc, cur, wr, wc, fr, fq);
        if (!has_next) break;
#pragma unroll
        for (int a = 0; a < 2; ++a)
#pragma unroll
            for (int b = 0; b < 2; ++b)
#pragma unroll
                for (int m = 0; m < 4; ++m)
#pragma unroll
                    for (int n = 0; n < 2; ++n) acc[a][b][m][n] = (f32x4){0.f, 0.f, 0.f, 0.f};
        cur = nxt; cA = nA; cB = nB; ++ui;
        if (wr == 1) PG8_BAR;
    }
    PG8_WAIT_V(0);
    PG8_BAR;
#undef PG8_SA
#undef PG8_SB
#undef PG8_STAGE
#undef PG8_LDA
#undef PG8_LDB
#undef PG8_MMA
#undef PG8_WAIT_V
#undef PG8_WAIT_L
#undef PG8_BAR
#undef PG8_SCHED
}
}
template <int MODE> struct EpiOut {
    static constexpr bool SYNC = false;
    bf16_t* O; float* Of; int ldc; const float* rowscale; float s; const float* bias; float* ssq;
    __device__ __forceinline__ void operator()(f32x4 (&acc)[2][2][4][2], const pg8::Unit& u, int wr, int wc, int fr, int fq) const {
        const int row0 = u.pm * 256 + wr * 64 + fr, col0 = u.pn * 256 + wc * 32 + 8 * fq;
        f32x4 bv[2][2];
        if (MODE == 2 || MODE == 3) {
#pragma unroll
            for (int bj = 0; bj < 2; ++bj)
#pragma unroll
                for (int n = 0; n < 2; ++n) bv[bj][n] = *(const f32x4*)(bias + col0 + bj * 128 + 4 * n);
        }
#pragma unroll
        for (int ai = 0; ai < 2; ++ai)
#pragma unroll
            for (int m = 0; m < 4; ++m) {
                const int row = row0 + ai * 128 + m * 16;
                float rs = 1.f; if (MODE == 1) rs = rowscale[row] * s;
                float q = 0.f;
#pragma unroll
                for (int bj = 0; bj < 2; ++bj) {
                    f32x4 v0 = acc[ai][bj][m][0], v1 = acc[ai][bj][m][1];
                    if (MODE == 1) { v0 = v0 * rs; v1 = v1 * rs; }
                    if (MODE == 2) {
                        v0 = v0 + bv[bj][0]; v1 = v1 + bv[bj][1];
#pragma unroll
                        for (int e = 0; e < 4; ++e) {
                            { const float y = -v0[e]; const float sp = fmaxf(y, 0.f) + __logf(1.f + __expf(-fabsf(y))); v0[e] = -__expf(-sp - 0.5f); }
                            { const float y = -v1[e]; const float sp = fmaxf(y, 0.f) + __logf(1.f + __expf(-fabsf(y))); v1[e] = -__expf(-sp - 0.5f); }
                        }
                        float* op = Of + (size_t)row * ldc + col0 + bj * 128;
                        *(f32x4*)op = v0; *(f32x4*)(op + 4) = v1;
                        continue;
                    }
                    if (MODE == 3) {
                        v0 = v0 + bv[bj][0]; v1 = v1 + bv[bj][1];
#pragma unroll
                        for (int e = 0; e < 4; ++e) { v0[e] = fast_sigmoid(v0[e]); v1[e] = fast_sigmoid(v1[e]); }
                    }
                    if (MODE == 4) { q += (v0[0] * v0[0] + v0[1] * v0[1]) + (v0[2] * v0[2] + v0[3] * v0[3]) + (v1[0] * v1[0] + v1[1] * v1[1]) + (v1[2] * v1[2] + v1[3] * v1[3]); }
                    u32x4 w; w.x = cvt_pk_bf16(v0[0], v0[1]); w.y = cvt_pk_bf16(v0[2], v0[3]); w.z = cvt_pk_bf16(v1[0], v1[1]); w.w = cvt_pk_bf16(v1[2], v1[3]);
                    *(u32x4*)(O + (size_t)row * ldc + col0 + bj * 128) = w;
                }
                if (MODE == 4) { q += __shfl_xor(q, 16); q += __shfl_xor(q, 32); if (fq == 0) ssq[(size_t)row * 32 + u.pn * 4 + wc] = q; }
            }
    }
};

struct EpiMulti {
    static constexpr bool SYNC = false;
    int mode; bf16_t* O; float* Of; int ldc; const float* rowscale; float s; const float* bias;
    __device__ __forceinline__ void operator()(f32x4 (&acc)[2][2][4][2], const pg8::Unit& u, int wr, int wc, int fr, int fq) const {
        const int row0 = u.pm * 256 + wr * 64 + fr, col0 = u.pn * 256 + wc * 32 + 8 * fq;
#pragma unroll 1
        for (int ai = 0; ai < 2; ++ai)
#pragma unroll
            for (int m = 0; m < 4; ++m) {
                const int row = row0 + ai * 128 + m * 16;
                const float rs = (mode == 1) ? rowscale[row] * s : 1.f;
#pragma unroll
                for (int bj = 0; bj < 2; ++bj) {
                    f32x4 v0 = ai ? acc[1][bj][m][0] : acc[0][bj][m][0], v1 = ai ? acc[1][bj][m][1] : acc[0][bj][m][1];
                    v0 = v0 * rs; v1 = v1 * rs;
                    if (mode >= 2) { v0 = v0 + *(const f32x4*)(bias + col0 + bj * 128); v1 = v1 + *(const f32x4*)(bias + col0 + bj * 128 + 4); }
                    if (mode == 2) {
#pragma unroll
                        for (int e = 0; e < 4; ++e) {
                            { const float y = -v0[e]; const float sp = fmaxf(y, 0.f) + __logf(1.f + __expf(-fabsf(y))); v0[e] = -__expf(-sp - 0.5f); }
                            { const float y = -v1[e]; const float sp = fmaxf(y, 0.f) + __logf(1.f + __expf(-fabsf(y))); v1[e] = -__expf(-sp - 0.5f); }
                        }
                        float* op = Of + (size_t)row * ldc + col0 + bj * 128;
                        *(f32x4*)op = v0; *(f32x4*)(op + 4) = v1;
                    } else {
                        if (mode == 3) {
#pragma unroll
                            for (int e = 0; e < 4; ++e) { v0[e] = fast_sigmoid(v0[e]); v1[e] = fast_sigmoid(v1[e]); }
                        }
                        u32x4 w; w.x = cvt_pk_bf16(v0[0], v0[1]); w.y = cvt_pk_bf16(v0[2], v0[3]); w.z = cvt_pk_bf16(v1[0], v1[1]); w.w = cvt_pk_bf16(v1[2], v1[3]);
                        *(u32x4*)(O + (size_t)row * ldc + col0 + bj * 128) = w;
                    }
                }
            }
    }
};

__device__ __forceinline__ float gelu_tanh(float x) {
    const float uu = x * (1.f + 0.044715f * x * x);
    return x * __builtin_amdgcn_rcpf(1.f + __builtin_amdgcn_exp2f(-2.f * 0.7978845608f * 1.4426950408889634f * uu));
}
__device__ __forceinline__ float dpp_ror1(float x) { return __int_as_float(__builtin_amdgcn_update_dpp(0, __float_as_int(x), 0x121, 0xf, 0xf, false)); }
__device__ __forceinline__ float dpp_ror2(float x) { return __int_as_float(__builtin_amdgcn_update_dpp(0, __float_as_int(x), 0x122, 0xf, 0xf, false)); }

struct EpiConv {
    static constexpr bool SYNC = true;
    bf16_t* ACT; const float* cw; const float* cb; float* HEADB; float* TAILB; LAS float* TB;
    __device__ __forceinline__ void operator()(f32x4 (&acc)[2][2][4][2], const pg8::Unit& u, int wr, int wc, int fr, int fq) const {
        const int lc0 = 32 * wc + 8 * fq;
        if (fr >= 14) {
            const int rs = fr - 14;
#pragma unroll
            for (int ai = 0; ai < 2; ++ai)
#pragma unroll
                for (int bj = 0; bj < 2; ++bj)
#pragma unroll
                    for (int n = 0; n < 2; ++n) *(LAS f32x4*)(TB + ((ai * 2 + wr) * 2 + rs) * 256 + bj * 128 + lc0 + 4 * n) = acc[ai][bj][3][n];
            if (wr == 1) {
#pragma unroll
                for (int bj = 0; bj < 2; ++bj)
#pragma unroll
                    for (int n = 0; n < 2; ++n) *(f32x4*)(TAILB + ((size_t)u.pm * 2 + rs) * UPW + u.pn * 256 + bj * 128 + lc0 + 4 * n) = acc[1][bj][3][n];
            }
        }
        if (wr == 0 && fr < 2) {
#pragma unroll
            for (int bj = 0; bj < 2; ++bj)
#pragma unroll
                for (int n = 0; n < 2; ++n) *(f32x4*)(HEADB + ((size_t)u.pm * 2 + fr) * UPW + u.pn * 256 + bj * 128 + lc0 + 4 * n) = acc[0][bj][0][n];
        }
        asm volatile("s_waitcnt lgkmcnt(0)" ::: "memory"); __builtin_amdgcn_s_barrier(); asm volatile("" ::: "memory");
        u32x2 pk0[2][4];
#pragma unroll
        for (int n = 0; n < 2; ++n) {
            const int ch = u.pn * 128 + lc0 + 4 * n;
            const f32x4 w0g = *(const f32x4*)(cw + ch), w1g = *(const f32x4*)(cw + UPW + ch), w2g = *(const f32x4*)(cw + 2 * UPW + ch), bg = *(const f32x4*)(cb + ch);
            const f32x4 w0v = *(const f32x4*)(cw + DFF + ch), w1v = *(const f32x4*)(cw + UPW + DFF + ch), w2v = *(const f32x4*)(cw + 2 * UPW + DFF + ch), bvv = *(const f32x4*)(cb + DFF + ch);
#pragma unroll
            for (int ai = 0; ai < 2; ++ai) {
                f32x4 tA[2], tB[2];
                const bool haspred = (wr == 1) || (ai == 1);
                const int pa = (wr == 1) ? ai : 0, pw = (wr == 1) ? 0 : 1;
#pragma unroll
                for (int bj = 0; bj < 2; ++bj) {
                    if (haspred) { tA[bj] = *(const LAS f32x4*)(TB + ((pa * 2 + pw) * 2 + 1) * 256 + bj * 128 + lc0 + 4 * n);
                                   tB[bj] = *(const LAS f32x4*)(TB + ((pa * 2 + pw) * 2 + (fr & 1)) * 256 + bj * 128 + lc0 + 4 * n); }
                    else { tA[bj] = (f32x4){0.f, 0.f, 0.f, 0.f}; tB[bj] = (f32x4){0.f, 0.f, 0.f, 0.f}; }
                }
#pragma unroll
                for (int m = 0; m < 4; ++m) {
                    f32x4 gc, vc;
#pragma unroll
                    for (int e = 0; e < 4; ++e) {
                        const float ug = acc[ai][0][m][n][e], uv = acc[ai][1][m][n][e];
                        float cg1 = dpp_ror1(ug), cg2 = dpp_ror2(ug), cv1 = dpp_ror1(uv), cv2 = dpp_ror2(uv);
                        float qg1 = tA[0][e], qg2 = tB[0][e], qv1 = tA[1][e], qv2 = tB[1][e];
                        if (m > 0) { qg1 = dpp_ror1(acc[ai][0][m > 0 ? m - 1 : 0][n][e]); qg2 = dpp_ror2(acc[ai][0][m > 0 ? m - 1 : 0][n][e]);
                                     qv1 = dpp_ror1(acc[ai][1][m > 0 ? m - 1 : 0][n][e]); qv2 = dpp_ror2(acc[ai][1][m > 0 ? m - 1 : 0][n][e]); }
                        asm volatile("" : "+v"(cg1), "+v"(cg2), "+v"(cv1), "+v"(cv2), "+v"(qg1), "+v"(qg2), "+v"(qv1), "+v"(qv2));
                        const float pg1 = (fr == 0) ? qg1 : cg1, pg2 = (fr < 2) ? qg2 : cg2;
                        const float pv1 = (fr == 0) ? qv1 : cv1, pv2 = (fr < 2) ? qv2 : cv2;
                        gc[e] = fmaf(w0g[e], pg2, fmaf(w1g[e], pg1, fmaf(w2g[e], ug, bg[e])));
                        vc[e] = fmaf(w0v[e], pv2, fmaf(w1v[e], pv1, fmaf(w2v[e], uv, bvv[e])));
                    }
                    u32x2 pk; pk.x = cvt_pk_bf16_asm(gelu_tanh(gc[0]) * vc[0], gelu_tanh(gc[1]) * vc[1]); pk.y = cvt_pk_bf16_asm(gelu_tanh(gc[2]) * vc[2], gelu_tanh(gc[3]) * vc[3]);
                    if (n == 0) pk0[ai][m] = pk;
                    else { const int row = u.pm * 256 + ai * 128 + wr * 64 + m * 16 + fr; u32x4 w; w.x = pk0[ai][m].x; w.y = pk0[ai][m].y; w.z = pk.x; w.w = pk.y;
                           *(u32x4*)(ACT + (size_t)row * DFF + u.pn * 128 + lc0) = w; }
                }
            }
        }
    }
};
constexpr int NWAVES = 8;
constexpr int RING_OFF = 0, RING_BYTES = 131072;
constexpr int TB_OFF = RING_BYTES;
constexpr int LDSCTL_OFF = RING_BYTES + 8192, MISC_OFF = LDSCTL_OFF + 320;
constexpr int LDS_BYTES = 147456;
constexpr int CW_BAR = 4096;
#define RLX_AGENT __ATOMIC_RELAXED, __HIP_MEMORY_SCOPE_AGENT
#define LDS_WAIT() asm volatile("s_waitcnt lgkmcnt(0)" ::: "memory")
#define VM_WAIT() asm volatile("s_waitcnt vmcnt(0)" ::: "memory")

#define XB_TMO      128
#define XB_XCNT(j)  (256  + 64 * (j))
#define XB_XSUB(j)  (1280 + 64 * (j))
#define XB_XGEN(j)  (2304 + 64 * (j))
#define XB_TOP      3328
#define XB_TOPGEN   3392
#define XCD_BAR_WORDS 3456
#define XB_SPIN_CAP (1u << 20)
__device__ __forceinline__ unsigned xb_ld(unsigned* p)              { return __hip_atomic_load(p, __ATOMIC_RELAXED, __HIP_MEMORY_SCOPE_AGENT); }
__device__ __forceinline__ unsigned xb_add(unsigned* p, unsigned v) { return __hip_atomic_fetch_add(p, v, __ATOMIC_RELAXED, __HIP_MEMORY_SCOPE_AGENT); }
__device__ __forceinline__ unsigned xb_xcc_id() { return (unsigned)__builtin_amdgcn_s_getreg((3 << 11) | 20) & 0xFu; }
#define XB_SPIN(cond, bar) do { unsigned _sp = 0; while (cond) { __builtin_amdgcn_s_sleep(1); \
    if ((++_sp & 255u) == 0u) { if (xb_ld(&(bar)[XB_TMO])) break; if (_sp > XB_SPIN_CAP) { atomicAdd(&(bar)[XB_TMO], 1u); break; } } } } while (0)
struct XcdBarrier { unsigned* bar; unsigned x; volatile LAS unsigned* st; };
__device__ __forceinline__ XcdBarrier xcd_barrier_post(unsigned* bar, volatile LAS unsigned* st) {
    XcdBarrier b; b.bar = bar; b.x = xb_xcc_id(); b.st = st;
    if (threadIdx.x == 0) (void)xb_add(&bar[XB_XCNT(b.x)], 1u);
    return b;
}
__device__ __forceinline__ void xcd_barrier_complete(unsigned* bar, unsigned x, unsigned& nloc, unsigned& nx) {
    const unsigned G = gridDim.x * gridDim.y * gridDim.z;
    unsigned sum, cnt, mine, sp = 0u;
    for (;;) {
        sum = 0u; cnt = 0u; mine = 0u;
#pragma unroll
        for (unsigned j = 0; j < 16; ++j) { const unsigned c = xb_ld(&bar[XB_XCNT(j)]); sum += c; cnt += (c > 0u) ? 1u : 0u; mine = (j == x) ? c : mine; }
        if (sum == G) break;
        __builtin_amdgcn_s_sleep(1);
        if ((++sp & 255u) == 0u) { if (xb_ld(&bar[XB_TMO])) break; if (sp > XB_SPIN_CAP) { atomicAdd(&bar[XB_TMO], 1u); break; } }
    }
    nloc = mine > 0u ? mine : 1u; nx = cnt > 0u ? cnt : 1u;
}
__device__ __forceinline__ void xcd_barrier(const XcdBarrier& b) {
    asm volatile("s_waitcnt vmcnt(0)" ::: "memory");
    __syncthreads();
    if (threadIdx.x == 0) {
        unsigned* bar = b.bar;
        __builtin_amdgcn_s_waitcnt(0);
        unsigned nloc = b.st[0], nx = b.st[1];
        if (nloc == 0u) { xcd_barrier_complete(bar, b.x, nloc, nx); b.st[0] = nloc; b.st[1] = nx; }
        const unsigned old = xb_add(&bar[XB_XSUB(b.x)], 1u);
        const unsigned gen = old / nloc;
        if (old + 1u == (gen + 1u) * nloc) {
            __builtin_amdgcn_fence(__ATOMIC_RELEASE, "agent");
            asm volatile("s_waitcnt vmcnt(0)" ::: "memory");
            const unsigned og = xb_add(&bar[XB_TOP], 1u);
            const unsigned tg = og / nx;
            if (og + 1u == (tg + 1u) * nx) xb_add(&bar[XB_TOPGEN], 1u);
            else XB_SPIN(xb_ld(&bar[XB_TOPGEN]) == tg, bar);
            __builtin_amdgcn_fence(__ATOMIC_ACQUIRE, "agent");
            xb_add(&bar[XB_XGEN(b.x)], 1u);
            asm volatile("s_waitcnt vmcnt(0)" ::: "memory");
        } else {
            XB_SPIN(xb_ld(&bar[XB_XGEN(b.x)]) == gen, bar);
            __builtin_amdgcn_fence(__ATOMIC_ACQUIRE, "agent");
            asm volatile("s_waitcnt vmcnt(0)" ::: "memory");
        }
    }
    __syncthreads();
}

struct Frame {
    LAS unsigned char* lds;
    volatile LAS unsigned* MISC;
    gu32* ctl;
    int tid, lane, wave, vcu, G;
    const float* in[30]; float* out; unsigned char* ws;
};
enum { I_X = 0, I_C, I_POS, I_WMOD, I_BMOD, I_GPREMIX, I_WIN, I_MU, I_W0, I_WDEC, I_A0, I_WICLR, I_WGATE, I_KK, I_KA, I_RK, I_LNG, I_LNB, I_QNG, I_WQ, I_KVNG, I_WKV,
       I_WOUT, I_GPOSTMIX, I_GPREFFN, I_WUP, I_CONVW, I_CONVB, I_WDOWN, I_GPOSTFFN };
__constant__ float INV_FREQ[32] = {1.000000000e+00f, 7.498942018e-01f, 5.623413324e-01f, 4.216965139e-01f, 3.162277639e-01f, 2.371373773e-01f, 1.778279394e-01f, 1.333521456e-01f,
    1.000000015e-01f, 7.498942316e-02f, 5.623413250e-02f, 4.216964915e-02f, 3.162277490e-02f, 2.371373773e-02f, 1.778279431e-02f, 1.333521400e-02f, 9.999999776e-03f, 7.498942316e-03f,
    5.623413250e-03f, 4.216964822e-03f, 3.162277630e-03f, 2.371373819e-03f, 1.778279431e-03f, 1.333521446e-03f, 1.000000047e-03f, 7.498941850e-04f, 5.623413017e-04f, 4.216965172e-04f,
    3.162277571e-04f, 2.371373703e-04f, 1.778279402e-04f, 1.333521504e-04f};

__device__ __forceinline__ float modv(const Frame& F, int b, int n) {
    const float* mp = (const float*)(F.ws + WS_MODP) + (size_t)b * 12288 + n;
    return ((mp[0] + mp[4 * 12288]) + (mp[8 * 12288] + mp[12 * 12288])) + F.in[I_BMOD][n];
}

__device__ __forceinline__ void phase_mod(Frame& F) {
    LAS f32x4* sc = (LAS f32x4*)F.lds;
    const float* c = F.in[I_C];
    for (int k = F.tid; k < DM; k += NWAVES * 64) { f32x4 v;
#pragma unroll
        for (int b = 0; b < 4; ++b) { const float x = c[b * DM + k]; v[b] = x * fast_sigmoid(x); }
        sc[k] = v; }
    __syncthreads();
    LAS float* red = (LAS float*)(F.lds + 32768);
    const float* wm = F.in[I_WMOD];
    float* modp = (float*)(F.ws + WS_MODP);
    const int cq = F.lane & 15, rs = F.lane >> 4;
    for (int it = blockIdx.x; it < 768; it += F.G) {
        const int kc = it / 192, nc = it % 192;
        f32x4 acc[4];
#pragma unroll
        for (int b = 0; b < 4; ++b) acc[b] = (f32x4){0.f, 0.f, 0.f, 0.f};
        const int kb = kc * 512 + F.wave * 64 + rs;
#pragma unroll 8
        for (int i = 0; i < 16; ++i) { const int k = kb + 4 * i; const f32x4 w = *(const f32x4*)(wm + (size_t)k * 12288 + nc * 64 + 4 * cq); const f32x4 s = sc[k];
#pragma unroll
            for (int b = 0; b < 4; ++b) acc[b] += w * s[b]; }
#pragma unroll
        for (int b = 0; b < 4; ++b) {
#pragma unroll
            for (int e = 0; e < 4; ++e) { float v = acc[b][e]; v += __shfl_xor(v, 16); v += __shfl_xor(v, 32); acc[b][e] = v; }
            if (rs == 0) *(LAS f32x4*)(red + (F.wave * 4 + b) * 64 + 4 * cq) = acc[b];
        }
        __syncthreads();
        if (F.tid < 256) { const int b = F.tid >> 6, col = F.tid & 63; float s = 0.f;
#pragma unroll
            for (int w = 0; w < 8; ++w) s += red[(w * 4 + b) * 64 + col];
            modp[(size_t)(kc * 4 + b) * 12288 + nc * 64 + col] = s; }
        __syncthreads();
    }
}

typedef short v4i16_t __attribute__((ext_vector_type(4)));
__device__ __forceinline__ void transpose_item(const float* W, int N, int Kvalid, const float* kscale, bf16_t* WT, int ldk, int k0, int n0s, int n0d, LAS char* scr, int lane) {
    const int r4 = lane >> 4, c = lane & 15;
    f32x4 v[16];
#pragma unroll
    for (int it = 0; it < 16; ++it) { const int k = k0 + 4 * it + r4; v[it] = (f32x4){0.f, 0.f, 0.f, 0.f}; if (k < Kvalid) v[it] = *(const f32x4*)(W + (size_t)k * N + n0s + 4 * c); }
#pragma unroll
    for (int it = 0; it < 16; ++it) { const int k = k0 + 4 * it + r4; f32x4 x = v[it]; if (kscale && k < Kvalid) x = x * kscale[k];
        u32x2 w; w.x = cvt_pk_bf16(x[0], x[1]); w.y = cvt_pk_bf16(x[2], x[3]);
        *(LAS u32x2*)(scr + (4 * it + r4) * 144 + c * 8) = w; }
    LDS_WAIT(); asm volatile("" ::: "memory");
    const int gi = lane >> 4, q = (lane >> 2) & 3, p = lane & 3, i = lane & 15;
#pragma unroll
    for (int j = 0; j < 8; ++j) { const int nb = 16 * (j >> 1), kk = 8 * (4 * (j & 1) + gi);
        const LAS char* ap = scr + (kk + q) * 144 + (nb + 4 * p) * 2;
        const v4i16_t lo = __builtin_amdgcn_ds_read_tr16_b64_v4i16((LAS v4i16_t*)ap), hi = __builtin_amdgcn_ds_read_tr16_b64_v4i16((LAS v4i16_t*)(ap + 4 * 144));
        bf16x8 o = (bf16x8){lo[0], lo[1], lo[2], lo[3], hi[0], hi[1], hi[2], hi[3]};
        *(bf16x8*)(WT + (size_t)(n0d + nb + i) * ldk + k0 + kk) = o; }
    LDS_WAIT(); asm volatile("" ::: "memory");
}
__device__ __forceinline__ void phase_weights(Frame& F, bool late, int gw, int NGW) {
    LAS char* scr = (LAS char*)(F.lds + F.wave * 9216);
    constexpr int I0 = 32 * 68, I1 = 8 * 24, I2 = 4 * 32, I3 = 32 * 32, I4 = 32 * 176, I5 = 88 * 32, I6 = 2 * 16, I7 = 2 * 16, I8 = 4 * 16;
    constexpr int NITEMS = I0 + I1 + I2 + I3 + I4 + I5 + I6 + I7 + I8;
    constexpr int NLATE = I3 + I4 + I5, NEARLY = NITEMS - NLATE;
#pragma unroll 1
    for (int it = gw; it < (late ? NLATE : NEARLY); it += NGW) {
        int r = late ? it + I0 + I1 + I2 : (it < I0 + I1 + I2 ? it : it + NLATE); const float* W; int N, Kv, ldk, kb, nb; const float* ks = nullptr; bf16_t* WT; bool up = false;
        if (r < I0) { W = F.in[I_WIN]; N = IN_COLS; Kv = DM; ldk = DM; WT = (bf16_t*)(F.ws + WS_WIN); kb = r / 68; nb = r % 68; }
        else if ((r -= I0) < I1) { W = F.in[I_WQ]; N = QW; Kv = QLR; ldk = QLR; WT = (bf16_t*)(F.ws + WS_WQ); ks = F.in[I_QNG]; kb = r / 24; nb = r % 24; }
        else if ((r -= I1) < I2) { W = F.in[I_WKV]; N = KVW; Kv = KVLR; ldk = KVLR; WT = (bf16_t*)(F.ws + WS_WKV); ks = F.in[I_KVNG]; kb = r / 32; nb = r % 32; }
        else if ((r -= I2) < I3) { W = F.in[I_WOUT]; N = DM; Kv = DM; ldk = DM; WT = (bf16_t*)(F.ws + WS_WOUT); kb = r / 32; nb = r % 32; }
        else if ((r -= I3) < I4) { W = F.in[I_WUP]; N = UPW; Kv = DM; ldk = DM; WT = (bf16_t*)(F.ws + WS_WUP); kb = r / 176; nb = r % 176; up = true; }
        else if ((r -= I4) < I5) { W = F.in[I_WDOWN]; N = DM; Kv = DFF; ldk = DFF; WT = (bf16_t*)(F.ws + WS_WDOWN); kb = r / 32; nb = r % 32; }
        else if ((r -= I5) < I6) { W = F.in[I_WDEC]; N = RW; Kv = 96; ldk = 128; WT = (bf16_t*)(F.ws + WS_WDEC); kb = r / 16; nb = r % 16; }
        else if ((r -= I6) < I7) { W = F.in[I_WICLR]; N = RW; Kv = 96; ldk = 128; WT = (bf16_t*)(F.ws + WS_WICLR); kb = r / 16; nb = r % 16; }
        else { r -= I7; W = F.in[I_WGATE]; N = RW; Kv = 256; ldk = 256; WT = (bf16_t*)(F.ws + WS_WGATE); kb = r / 16; nb = r % 16; }
        const int n0d = 64 * nb; int n0s = n0d;
        if (up) { const int pn = n0d >> 8, bj = (n0d >> 7) & 1, j0 = n0d & 127; n0s = bj * DFF + 128 * pn + j0; }
        transpose_item(W, N, Kv, ks, WT, ldk, 64 * kb, n0s, n0d, scr, F.lane);
    }
}
__device__ __forceinline__ void phase_convcopy(Frame& F) {
    float* dst = (float*)(F.ws + WS_CONV);
    const int gt = F.vcu * NWAVES * 64 + F.tid, NT = F.G * NWAVES * 64;
    for (int i = gt; i < 4 * UPW; i += NT) dst[i] = (i < 3 * UPW) ? F.in[I_CONVW][i] : F.in[I_CONVB][i - 3 * UPW];
}
__device__ __forceinline__ void norm_mod_row(const float* xrow, bf16_t* orow, const LAS float* Am, const LAS float* Bm, int lane) {
    const f32x4* xr = (const f32x4*)xrow + lane;
    f32x4 v[8]; float s = 0.f;
#pragma unroll
    for (int j = 0; j < 8; ++j) { v[j] = xr[64 * j]; s += (v[j][0] * v[j][0] + v[j][1] * v[j][1]) + (v[j][2] * v[j][2] + v[j][3] * v[j][3]); }
    const float rstd = rsqrtf(wave_sum(s) * (1.f / DM) + NORM_EPS);
    u32x2* o8 = (u32x2*)orow + lane;
#pragma unroll
    for (int j = 0; j < 8; ++j) { const f32x4 a = *(const LAS f32x4*)(Am + 4 * (lane + 64 * j)), b = *(const LAS f32x4*)(Bm + 4 * (lane + 64 * j));
        const f32x4 y = v[j] * rstd * a + b; u32x2 w; w.x = cvt_pk_bf16(y[0], y[1]); w.y = cvt_pk_bf16(y[2], y[3]); o8[64 * j] = w; }
}
__device__ __forceinline__ void phase_hprep(Frame& F) {
    LAS float* Am = (LAS float*)(F.lds + 73728); LAS float* Bm = (LAS float*)(F.lds + 81920);
    const float* x = F.in[I_X]; bf16_t* H = (bf16_t*)(F.ws + WS_H);
    for (int rb = F.vcu; rb < TOK / 64; rb += F.G) {
        const int b = (rb * 64) / SEQ;
        __syncthreads();
        for (int k = F.tid; k < DM; k += NWAVES * 64) { Am[k] = F.in[I_GPREMIX][k] * (1.f + modv(F, b, 2048 + k)); Bm[k] = modv(F, b, k); }
        __syncthreads();
        for (int rr = F.wave; rr < 64; rr += NWAVES) { const size_t row = (size_t)rb * 64 + rr; norm_mod_row(x + row * DM, H + row * DM, Am, Bm, F.lane); }
    }
}

__device__ __forceinline__ void phase_tokprep(Frame& F) {
    const bf16_t* P = (const bf16_t*)(F.ws + WS_P);
    float* rq = (float*)(F.ws + WS_RSTDQ); float* rkv = (float*)(F.ws + WS_RSTDKV);
    bf16_t* KR = (bf16_t*)(F.ws + WS_KR); f32x2* CS = (f32x2*)(F.ws + WS_CS); bf16_t* LA = (bf16_t*)(F.ws + WS_LA);
    const int* pos = (const int*)F.in[I_POS]; const float* mu = F.in[I_MU];
    const int gw = F.vcu * NWAVES + F.wave, NGW = F.G * NWAVES, lane = F.lane;
    for (int row = gw; row < TOK; row += NGW) {
        const bf16_t* pr = P + (size_t)row * IN_COLS; const bool hp = (row % SEQ) != 0; const bf16_t* pp = pr - IN_COLS;
        { const u32x4 q = *(const u32x4*)(pr + C_QL + lane * 8); float s = 0.f;
#pragma unroll
          for (int i = 0; i < 4; ++i) { const float a = bflo(q[i]), b = bfhi(q[i]); s += a * a + b * b; }
          s = wave_sum(s); if (lane == 0) rq[row] = rsqrtf(s * (1.f / QLR) + NORM_EPS); }
        { const u32x2 q = *(const u32x2*)(pr + C_KVL + lane * 4); float s = 0.f;
#pragma unroll
          for (int i = 0; i < 2; ++i) { const float a = bflo(q[i]), b = bfhi(q[i]); s += a * a + b * b; }
          s = wave_sum(s); if (lane == 0) rkv[row] = rsqrtf(s * (1.f / KVLR) + NORM_EPS); }
        if (lane < 32) {
            const float ang = (float)pos[row] * INV_FREQ[lane];
            double a = (double)ang * 0.15915494309189535; a -= __builtin_rint(a); const float fr = (float)a;
            const float cs = __builtin_amdgcn_cosf(fr), sn = __builtin_amdgcn_sinf(fr);
            const float u1 = bf2f(pr[C_KR + lane]), u2 = bf2f(pr[C_KR + 32 + lane]);
            KR[(size_t)row * 64 + lane] = f2bf(u1 * cs - u2 * sn); KR[(size_t)row * 64 + 32 + lane] = f2bf(u1 * sn + u2 * cs);
            CS[(size_t)row * 32 + lane] = (f32x2){cs, sn};
        }
        bf16_t* la = LA + (size_t)row * LAW;
        if (lane < 48) {
#pragma unroll
            for (int part = 0; part < 2; ++part) { const int c0 = (part ? C_AD : C_WD) + 2 * lane;
                const unsigned cur = *(const unsigned*)(pr + c0); const unsigned prv = hp ? *(const unsigned*)(pp + c0) : 0u;
                const float m0 = mu[c0], m1 = mu[c0 + 1];
                float v0 = bflo(cur), v1 = bfhi(cur); v0 += (bflo(prv) - v0) * m0; v1 += (bfhi(prv) - v1) * m1;
                if (part == 0) { v0 = fast_tanh(v0); v1 = fast_tanh(v1); }
                *(unsigned*)(la + part * 128 + 2 * lane) = cvt_pk_bf16(v0, v1); }
        } else {
            *(unsigned*)(la + 96 + 2 * (lane - 48)) = 0u; *(unsigned*)(la + 128 + 96 + 2 * (lane - 48)) = 0u;
        }
        { const int c0 = C_GD + 4 * lane; const u32x2 cur = *(const u32x2*)(pr + c0); u32x2 prv = (u32x2){0u, 0u}; if (hp) prv = *(const u32x2*)(pp + c0);
          const f32x4 m = *(const f32x4*)(mu + c0);
          float v0 = bflo(cur.x), v1 = bfhi(cur.x), v2 = bflo(cur.y), v3 = bfhi(cur.y);
          v0 += (bflo(prv.x) - v0) * m[0]; v1 += (bfhi(prv.x) - v1) * m[1]; v2 += (bflo(prv.y) - v2) * m[2]; v3 += (bfhi(prv.y) - v3) * m[3];
          u32x2 w; w.x = cvt_pk_bf16(fast_sigmoid(v0), fast_sigmoid(v1)); w.y = cvt_pk_bf16(fast_sigmoid(v2), fast_sigmoid(v3));
          *(u32x2*)(la + 256 + 4 * lane) = w; }
    }
}

__device__ __forceinline__ void phase_mid(Frame& F) {
    LAS float* Gm = (LAS float*)(F.lds + 0); LAS float* Af = (LAS float*)(F.lds + 8192); LAS float* Bf = (LAS float*)(F.lds + 16384);
    const float* x = F.in[I_X]; bf16_t* H = (bf16_t*)(F.ws + WS_H); const bf16_t* O1 = (const bf16_t*)(F.ws + WS_O1); const float* ssq = (const float*)(F.ws + WS_SSQ1);
    const int lane = F.lane;
    for (int rb = F.vcu; rb < TOK / 64; rb += F.G) {
        const int b = (rb * 64) / SEQ;
        __syncthreads();
        for (int k = F.tid; k < DM; k += NWAVES * 64) { Gm[k] = F.in[I_GPOSTMIX][k] * modv(F, b, 4096 + k); Af[k] = F.in[I_GPREFFN][k] * (1.f + modv(F, b, 8192 + k)); Bf[k] = modv(F, b, 6144 + k); }
        __syncthreads();
        for (int rr = F.wave; rr < 64; rr += NWAVES) {
            const size_t row = (size_t)rb * 64 + rr;
            float sq = (lane < 32) ? ssq[row * 32 + lane] : 0.f; sq = wave_sum(sq);
            const float rstd1 = rsqrtf(sq * (1.f / DM) + NORM_EPS);
            const f32x4* xr = (const f32x4*)(x + row * DM) + lane; const u32x2* orow = (const u32x2*)(O1 + row * DM) + lane; u32x2* xo = (u32x2*)((bf16_t*)(F.ws + WS_X2) + row * DM) + lane;
            f32x4 v[8]; float s = 0.f;
#pragma unroll
            for (int j = 0; j < 8; ++j) { const f32x4 xv = xr[64 * j]; const u32x2 ov = orow[64 * j]; const f32x4 g = *(const LAS f32x4*)(Gm + 4 * (lane + 64 * j));
                f32x4 o; o[0] = bflo(ov.x); o[1] = bfhi(ov.x); o[2] = bflo(ov.y); o[3] = bfhi(ov.y);
                v[j] = xv + g * (o * rstd1); { u32x2 w2; w2.x = cvt_pk_bf16(v[j][0], v[j][1]); w2.y = cvt_pk_bf16(v[j][2], v[j][3]); xo[64 * j] = w2; }
                s += (v[j][0] * v[j][0] + v[j][1] * v[j][1]) + (v[j][2] * v[j][2] + v[j][3] * v[j][3]); }
            const float rstd2 = rsqrtf(wave_sum(s) * (1.f / DM) + NORM_EPS);
            u32x2* o8 = (u32x2*)(H + row * DM) + lane;
#pragma unroll
            for (int j = 0; j < 8; ++j) { const f32x4 a = *(const LAS f32x4*)(Af + 4 * (lane + 64 * j)), bb = *(const LAS f32x4*)(Bf + 4 * (lane + 64 * j));
                const f32x4 y = v[j] * rstd2 * a + bb; u32x2 w; w.x = cvt_pk_bf16(y[0], y[1]); w.y = cvt_pk_bf16(y[2], y[3]); o8[64 * j] = w; }
        }
    }
}

__device__ __forceinline__ void fixup_panel(Frame& F, int pm) {
    if ((pm & 15) == 0) return;
    const float* HEADB = (const float*)(F.ws + WS_HEAD); const float* TAILB = (const float*)(F.ws + WS_TAIL); bf16_t* ACT = (bf16_t*)(F.ws + WS_ACT);
    const float* cw = (const float*)(F.ws + WS_CONV); const float* cb = cw + 3 * UPW;
    const float* h0 = HEADB + ((size_t)pm * 2 + 0) * UPW; const float* h1 = h0 + UPW; const float* t0 = TAILB + ((size_t)(pm - 1) * 2 + 0) * UPW; const float* t1 = t0 + UPW;
    for (int i = F.tid; i < 2 * DFF; i += NWAVES * 64) {
        const int cc = i % DFF, rr = i / DFF;
        const int ng = 256 * (cc >> 7) + (cc & 127), nv = ng + 128;
        float ug, uv, pg1, pg2, pv1, pv2;
        if (rr == 0) { ug = h0[ng]; uv = h0[nv]; pg1 = t1[ng]; pv1 = t1[nv]; pg2 = t0[ng]; pv2 = t0[nv]; }
        else { ug = h1[ng]; uv = h1[nv]; pg1 = h0[ng]; pv1 = h0[nv]; pg2 = t1[ng]; pv2 = t1[nv]; }
        const float gc = fmaf(cw[cc], pg2, fmaf(cw[UPW + cc], pg1, fmaf(cw[2 * UPW + cc], ug, cb[cc])));
        const float vc = fmaf(cw[DFF + cc], pv2, fmaf(cw[UPW + DFF + cc], pv1, fmaf(cw[2 * UPW + DFF + cc], uv, cb[DFF + cc])));
        ACT[(size_t)(pm * 256 + rr) * DFF + cc] = f2bf(gelu_tanh(gc) * vc);
    }
}

__device__ __forceinline__ void phase_final(Frame& F) {
    LAS float* Gm = (LAS float*)(F.lds + 0);
    const bf16_t* O2 = (const bf16_t*)(F.ws + WS_O2); const float* ssq = (const float*)(F.ws + WS_SSQ2);
    const int lane = F.lane;
    for (int rb = F.vcu; rb < TOK / 64; rb += F.G) {
        const int b = (rb * 64) / SEQ;
        __syncthreads();
        for (int k = F.tid; k < DM; k += NWAVES * 64) Gm[k] = F.in[I_GPOSTFFN][k] * modv(F, b, 10240 + k);
        __syncthreads();
        for (int rr = F.wave; rr < 64; rr += NWAVES) {
            const size_t row = (size_t)rb * 64 + rr;
            float sq = (lane < 32) ? ssq[row * 32 + lane] : 0.f; sq = wave_sum(sq);
            const float rstd = rsqrtf(sq * (1.f / DM) + NORM_EPS);
            const u32x2* orow = (const u32x2*)(O2 + row * DM) + lane; f32x4* xo = (f32x4*)(F.out + row * DM) + lane; const u32x2* x2r = (const u32x2*)((const bf16_t*)(F.ws + WS_X2) + row * DM) + lane;
#pragma unroll
            for (int j = 0; j < 8; ++j) { const u32x2 xb = x2r[64 * j]; const f32x4 xv = (f32x4){bflo(xb.x), bfhi(xb.x), bflo(xb.y), bfhi(xb.y)}; const u32x2 ov = orow[64 * j]; const f32x4 g = *(const LAS f32x4*)(Gm + 4 * (lane + 64 * j));
                f32x4 o; o[0] = bflo(ov.x); o[1] = bfhi(ov.x); o[2] = bflo(ov.y); o[3] = bfhi(ov.y);
                xo[64 * j] = xv + g * (o * rstd); }
        }
    }
}
namespace att {
constexpr int NW = 8, QBLK = 32, KVBLK = 64;
constexpr int SHM_V = 16384, SHM_K = 16384, SHM_KR = 8192;
constexpr int OFF_V = 0, OFF_K = 2 * SHM_V, OFF_KR = OFF_K + 2 * SHM_K, OFF_WS = OFF_KR + 2 * SHM_KR, SHM_ATTN = OFF_WS + NW * 64 * 4;
constexpr float THR = 8.f;
#define KSWZ(row, colB) ((row) * 256 + ((colB) ^ (((row) & 7) << 4)))
#define KRSWZ(row, colB) ((row) * 128 + ((colB) ^ ((((row) >> 1) & 7) << 4)))
#define SBAR() __builtin_amdgcn_sched_barrier(0)
__device__ __forceinline__ int crow(int r, int hi) { return (r & 3) + 8 * (r >> 2) + 4 * hi; }
__device__ __forceinline__ void partialSM(f32x16& p0, f32x16& p1, float& m_reg, float& mn, float& alpha) {
    float pmax = p0[0];
#pragma unroll
    for (int r = 1; r < 16; ++r) pmax = fmaxf(pmax, p0[r]);
#pragma unroll
    for (int r = 0; r < 16; ++r) pmax = fmaxf(pmax, p1[r]);
    { auto rr = __builtin_amdgcn_permlane32_swap(__float_as_uint(pmax), __float_as_uint(pmax), false, false);
      pmax = fmaxf(__uint_as_float(rr[0]), __uint_as_float(rr[1])); }
    if (__builtin_expect(__all(pmax - m_reg <= THR), 1)) { mn = m_reg; alpha = 1.f; }
    else { mn = fmaxf(m_reg, pmax); alpha = __builtin_amdgcn_exp2f(m_reg - mn); m_reg = mn; }
#pragma unroll
    for (int r = 0; r < 16; ++r) { p0[r] = p0[r] - mn; p1[r] = p1[r] - mn; }
#pragma unroll
    for (int r = 0; r < 16; ++r) p0[r] = __builtin_amdgcn_exp2f(p0[r]);
}
__device__ __forceinline__ void finishSM(f32x16& p0, f32x16& p1, float alpha, float& l_reg, bf16x8& pa0, bf16x8& pa1, bf16x8& pa2, bf16x8& pa3) {
#pragma unroll
    for (int r = 0; r < 16; ++r) p1[r] = __builtin_amdgcn_exp2f(p1[r]);
    float ps = 0;
#pragma unroll
    for (int r = 0; r < 16; ++r) ps += p0[r];
#pragma unroll
    for (int r = 0; r < 16; ++r) ps += p1[r];
    { auto rr = __builtin_amdgcn_permlane32_swap(__float_as_uint(ps), __float_as_uint(ps), false, false);
      ps = __uint_as_float(rr[0]) + __uint_as_float(rr[1]); }
    l_reg = l_reg * alpha + ps;
#define PK4(P, BASE, OUT) do { unsigned a0 = cvt_pk_bf16(P[BASE + 0], P[BASE + 1]), a1 = cvt_pk_bf16(P[BASE + 2], P[BASE + 3]);   \
    unsigned b0 = cvt_pk_bf16(P[BASE + 4], P[BASE + 5]), b1 = cvt_pk_bf16(P[BASE + 6], P[BASE + 7]);                              \
    auto r0 = __builtin_amdgcn_permlane32_swap(a0, b0, false, false); auto r1 = __builtin_amdgcn_permlane32_swap(a1, b1, false, false); \
    u32x4 w = {r0[0], r1[0], r0[1], r1[1]}; OUT = *reinterpret_cast<bf16x8*>(&w); } while (0)
    PK4(p0, 0, pa0); PK4(p0, 8, pa1); PK4(p1, 0, pa2); PK4(p1, 8, pa3);
#undef PK4
}
__device__ __forceinline__ void qkt(f32x16& p0, f32x16& p1, const char* Ks, const char* KRs, const bf16x8* qr, int r32, int hi) {
    p0 = f32x16{}; p1 = f32x16{};
#pragma unroll
    for (int d0 = 0; d0 < 8; ++d0) { const int cb = (d0 * 16 + hi * 8) * 2;
        const bf16x8 b0 = *reinterpret_cast<const bf16x8*>(Ks + KSWZ(r32, cb));
        const bf16x8 b1 = *reinterpret_cast<const bf16x8*>(Ks + KSWZ(32 + r32, cb));
        p0 = __builtin_amdgcn_mfma_f32_32x32x16_bf16(b0, qr[d0], p0, 0, 0, 0);
        p1 = __builtin_amdgcn_mfma_f32_32x32x16_bf16(b1, qr[d0], p1, 0, 0, 0); }
#pragma unroll
    for (int d0 = 0; d0 < 4; ++d0) { const int cb = (d0 * 16 + hi * 8) * 2;
        const bf16x8 b0 = *reinterpret_cast<const bf16x8*>(KRs + KRSWZ(r32, cb));
        const bf16x8 b1 = *reinterpret_cast<const bf16x8*>(KRs + KRSWZ(32 + r32, cb));
        p0 = __builtin_amdgcn_mfma_f32_32x32x16_bf16(b0, qr[8 + d0], p0, 0, 0, 0);
        p1 = __builtin_amdgcn_mfma_f32_32x32x16_bf16(b1, qr[8 + d0], p1, 0, 0, 0); }
}
__device__ __forceinline__ int v_st(int k, int c) { const int kk = (k & ~0xC) | ((k & 4) << 1) | ((k & 8) >> 1); return ((kk >> 3) * 4 + (c >> 5)) * 512 + ((kk & 7) * 32 + (c & 31)) * 2; }
__device__ __forceinline__ int v_rd_base(int lane) { return ((lane & 3) << 3) | (((lane >> 2) & 3) << 6) | (((lane >> 4) & 1) << 5) | (((lane >> 5) & 1) << 8); }
constexpr int v_rd_off(int d0, int ks, int half) { return d0 * 512 + ks * 4096 + half * 2048; }
template <int OFF> __device__ __forceinline__ s16x4 tr_read(int vb) {
    s16x4 r; asm volatile("ds_read_b64_tr_b16 %0, %1 offset:%2" : "=&v"(r) : "v"(vb), "i"(OFF) : "memory"); return r;
}
template <int D0> __device__ __forceinline__ void pv_one(f32x16& od, int vb, bf16x8 pa0, bf16x8 pa1, bf16x8 pa2, bf16x8 pa3) {
    const s16x4 l0 = tr_read<v_rd_off(D0, 0, 0)>(vb), h0 = tr_read<v_rd_off(D0, 0, 1)>(vb), l1 = tr_read<v_rd_off(D0, 1, 0)>(vb), h1 = tr_read<v_rd_off(D0, 1, 1)>(vb);
    const s16x4 l2 = tr_read<v_rd_off(D0, 2, 0)>(vb), h2 = tr_read<v_rd_off(D0, 2, 1)>(vb), l3 = tr_read<v_rd_off(D0, 3, 0)>(vb), h3 = tr_read<v_rd_off(D0, 3, 1)>(vb);
    asm volatile("s_waitcnt lgkmcnt(0)" ::: "memory"); SBAR();
#define PK(L, H) (bf16x8){L[0], L[1], L[2], L[3], H[0], H[1], H[2], H[3]}
    od = __builtin_amdgcn_mfma_f32_32x32x16_bf16(pa0, PK(l0, h0), od, 0, 0, 0);
    od = __builtin_amdgcn_mfma_f32_32x32x16_bf16(pa1, PK(l1, h1), od, 0, 0, 0);
    od = __builtin_amdgcn_mfma_f32_32x32x16_bf16(pa2, PK(l2, h2), od, 0, 0, 0);
    od = __builtin_amdgcn_mfma_f32_32x32x16_bf16(pa3, PK(l3, h3), od, 0, 0, 0);
#undef PK
}
__device__ __forceinline__ void pv_d0(f32x16* o, int vb, bf16x8 pa0, bf16x8 pa1, bf16x8 pa2, bf16x8 pa3) {
    pv_one<0>(o[0], vb, pa0, pa1, pa2, pa3); pv_one<1>(o[1], vb, pa0, pa1, pa2, pa3); pv_one<2>(o[2], vb, pa0, pa1, pa2, pa3); pv_one<3>(o[3], vb, pa0, pa1, pa2, pa3);
}

__device__ __forceinline__ void attn_unit(int b, int h, int qb, const bf16_t* __restrict__ Qg, const bf16_t* __restrict__ KVg, const bf16_t* __restrict__ KRg, const f32x2* __restrict__ CSg,
                                          bf16_t* __restrict__ Yg, char* lds) {
    const int tid = threadIdx.x, wid = __builtin_amdgcn_readfirstlane(tid >> 6), lane = tid & 63, r32 = lane & 31, hi = lane >> 5;
    char* V_lds = lds + OFF_V; char* K_lds = lds + OFF_K; char* KR_lds = lds + OFF_KR;
    float* ws = (float*)(lds + OFF_WS) + wid * 64; float* li_l = ws; float* al_l = ws + 32;
    const int q0 = qb * 256, NT = 4 * qb + 4, nt_w = 4 * qb + (wid >> 1) + 1;
    const size_t tok0 = (size_t)b * SEQ;
    float m_reg = -1e30f, l_reg = 0; f32x16 o[4] = {}; bf16x8 qr[12];
    { const size_t qrow = tok0 + q0 + wid * QBLK + r32;
      const bf16_t* Qw = Qg + qrow * QW + h * QHD + hi * 8;
#pragma unroll
      for (int d0 = 0; d0 < 12; ++d0) qr[d0] = *reinterpret_cast<const bf16x8*>(Qw + d0 * 16);
      const f32x2* cs = CSg + qrow * 32 + hi * 8;
#pragma unroll
      for (int dd = 0; dd < 2; ++dd) {
          bf16x8 x1 = qr[8 + dd], x2 = qr[10 + dd]; float y1[8], y2[8];
#pragma unroll
          for (int j = 0; j < 8; ++j) { const f32x2 c = cs[dd * 16 + j]; const float a = bf2f((unsigned short)x1[j]), bb = bf2f((unsigned short)x2[j]);
              y1[j] = a * c[0] - bb * c[1]; y2[j] = a * c[1] + bb * c[0]; }
          u32x4 w1 = {cvt_pk_bf16(y1[0], y1[1]), cvt_pk_bf16(y1[2], y1[3]), cvt_pk_bf16(y1[4], y1[5]), cvt_pk_bf16(y1[6], y1[7])};
          u32x4 w2 = {cvt_pk_bf16(y2[0], y2[1]), cvt_pk_bf16(y2[2], y2[3]), cvt_pk_bf16(y2[4], y2[5]), cvt_pk_bf16(y2[6], y2[7])};
          qr[8 + dd] = *reinterpret_cast<bf16x8*>(&w1); qr[10 + dd] = *reinterpret_cast<bf16x8*>(&w2);
      } }
    const bf16_t* Kh = KVg + tok0 * KVW + h * 256; const bf16_t* Vh = Kh + 128; const bf16_t* KRb = KRg + tok0 * 64;
    const int sr = tid >> 4, sc = (tid & 15) * 8, vst0 = v_st(sr, sc), vst1 = v_st(32 + sr, sc);
    const int krr = tid >> 3, krc = (tid & 7) * 8;
    const int vb0 = (int)(uintptr_t)V_lds + v_rd_base(lane);
    bf16x8 s_vs0, s_vs1, s_ks0, s_ks1, s_kr;
#define SLOAD(k0) do { s_vs0 = *reinterpret_cast<const bf16x8*>(&Vh[(size_t)((k0) + sr) * KVW + sc]); s_vs1 = *reinterpret_cast<const bf16x8*>(&Vh[(size_t)((k0) + 32 + sr) * KVW + sc]); \
    s_ks0 = *reinterpret_cast<const bf16x8*>(&Kh[(size_t)((k0) + sr) * KVW + sc]); s_ks1 = *reinterpret_cast<const bf16x8*>(&Kh[(size_t)((k0) + 32 + sr) * KVW + sc]); \
    s_kr = *reinterpret_cast<const bf16x8*>(&KRb[(size_t)((k0) + krr) * 64 + krc]); } while (0)
#define SWRITE(bb) do { *(bf16x8*)(V_lds + (bb) * SHM_V + vst0) = s_vs0; *(bf16x8*)(V_lds + (bb) * SHM_V + vst1) = s_vs1; const int kc = sc * 2; \
    *(bf16x8*)(K_lds + (bb) * SHM_K + KSWZ(sr, kc)) = s_ks0; *(bf16x8*)(K_lds + (bb) * SHM_K + KSWZ(32 + sr, kc)) = s_ks1; \
    *(bf16x8*)(KR_lds + (bb) * SHM_KR + KRSWZ(krr, krc * 2)) = s_kr; } while (0)
#define SWAIT() asm volatile("s_waitcnt vmcnt(0)" ::: "memory")
#define RESC(a) do { if (__any((a) < 1.f)) { if (hi == 0) al_l[r32] = (a); asm volatile("s_waitcnt lgkmcnt(0)" ::: "memory"); \
    _Pragma("unroll") for (int d = 0; d < 4; ++d) _Pragma("unroll") for (int r = 0; r < 16; ++r) o[d][r] *= al_l[crow(r, hi)]; } } while (0)
#define ACTV(j) ((j) < nt_w)
    f32x16 p0, p1; float mn, al = 1.f; bf16x8 pa0, pa1, pa2, pa3;
    SLOAD(0); SWAIT(); SWRITE(0); __syncthreads();
    for (int j = 0; j < NT; ++j) {
        const int bsel = j & 1;
        if (j + 1 < NT) SLOAD((j + 1) * KVBLK);
        if (ACTV(j)) {
            qkt(p0, p1, K_lds + bsel * SHM_K, KR_lds + bsel * SHM_KR, qr, r32, hi);
            partialSM(p0, p1, m_reg, mn, al);
            RESC(al);
            finishSM(p0, p1, al, l_reg, pa0, pa1, pa2, pa3); SBAR();
            pv_d0(o, vb0 + bsel * SHM_V, pa0, pa1, pa2, pa3);
        }
        if (j + 1 < NT) { SWAIT(); SWRITE(bsel ^ 1); }
        __syncthreads();
    }
    if (hi == 0) li_l[r32] = l_reg; asm volatile("s_waitcnt lgkmcnt(0)" ::: "memory");
    float rli[16];
#pragma unroll
    for (int r = 0; r < 16; ++r) rli[r] = __builtin_amdgcn_rcpf(li_l[crow(r, hi)]);
    bf16_t* Yw = Yg + (tok0 + q0 + wid * QBLK) * DM + RW + h * DV;
#pragma unroll
    for (int r = 0; r < 16; ++r) { const int orow = crow(r, hi);
#pragma unroll
        for (int d0 = 0; d0 < 4; ++d0) Yw[(size_t)orow * DM + d0 * 32 + r32] = f2bf(o[d0][r] * rli[r]); }
    __syncthreads();
#undef SLOAD
#undef SWRITE
#undef SWAIT
#undef RESC
#undef ACTV
}
#undef SBAR
}
namespace rk {
constexpr int LDM = 72, MB = 64 * LDM * 2;
constexpr int FP = 68;
struct Bufs { bf16_t* G; bf16_t* H; bf16_t* Qe; bf16_t* Yi; bf16_t* S0; float* PC; float* BON; };
__device__ __forceinline__ LAS char* mbuf(LAS unsigned char* lds, int i) { return (LAS char*)lds + i * MB; }

__device__ __forceinline__ f32x4 tile64(const LAS char* Aq, const LAS char* Bp, int tq, int tp, int lane, f32x4 acc) {
    const int r = lane & 15, kq = lane >> 4;
    const LAS char* ap = Aq + (tq * 16 + r) * (LDM * 2) + kq * 16; const LAS char* bp = Bp + (tp * 16 + r) * (LDM * 2) + kq * 16;
    const bf16x8 a0 = *(const LAS bf16x8*)ap, a1 = *(const LAS bf16x8*)(ap + 64), b0 = *(const LAS bf16x8*)bp, b1 = *(const LAS bf16x8*)(bp + 64);
    acc = __builtin_amdgcn_mfma_f32_16x16x32_bf16(a0, b0, acc, 0, 0, 0);
    return __builtin_amdgcn_mfma_f32_16x16x32_bf16(a1, b1, acc, 0, 0, 0);
}
__device__ __forceinline__ void st_pq(LAS char* dst, int tq, int tp, int lane, f32x4 v) {
    u32x2 w; w.x = cvt_pk_bf16(v[0], v[1]); w.y = cvt_pk_bf16(v[2], v[3]);
    *(LAS u32x2*)(dst + (tp * 16 + (lane & 15)) * (LDM * 2) + (tq * 16 + 4 * (lane >> 4)) * 2) = w;
}
__device__ __forceinline__ void st_qp(LAS char* dstT, int tq, int tp, int lane, f32x4 v) {
#pragma unroll
    for (int e = 0; e < 4; ++e) *(LAS bf16_t*)(dstT + (tq * 16 + 4 * (lane >> 4) + e) * (LDM * 2) + (tp * 16 + (lane & 15)) * 2) = f2bf(v[e]);
}
__device__ __forceinline__ f32x4 ld_pq(const LAS char* src, int tq, int tp, int lane) {
    const u32x2 w = *(const LAS u32x2*)(src + (tp * 16 + (lane & 15)) * (LDM * 2) + (tq * 16 + 4 * (lane >> 4)) * 2);
    return (f32x4){bflo(w.x), bfhi(w.x), bflo(w.y), bfhi(w.y)};
}
__device__ __forceinline__ void gst_pq(bf16_t* dst, int tq, int tp, int lane, f32x4 v) {
    u32x2 w; w.x = cvt_pk_bf16(v[0], v[1]); w.y = cvt_pk_bf16(v[2], v[3]);
    *(u32x2*)(dst + (tp * 16 + (lane & 15)) * 64 + tq * 16 + 4 * (lane >> 4)) = w;
}
#define RK_BAR() do { asm volatile("s_waitcnt lgkmcnt(0)" ::: "memory"); __builtin_amdgcn_s_barrier(); asm volatile("" ::: "memory"); } while (0)

#if MK_CHECK
__device__ __forceinline__ void dbg_scan(Frame& F, int buf, int slot) {
    unsigned* fl = (unsigned*)(F.ws + WS_CTL) + 8 + 2 * slot; const LAS char* m = mbuf(F.lds, buf) + (F.tid >> 3) * (LDM * 2) + (F.tid & 7) * 16;
    const u32x4 w = *(const LAS u32x4*)m; float mx = 0.f; bool nf = false;
#pragma unroll
    for (int j = 0; j < 4; ++j) { const float a = bflo(w[j]), b = bfhi(w[j]); if (!(fabsf(a) <= 3e38f) || !(fabsf(b) <= 3e38f)) nf = true; else mx = fmaxf(mx, fmaxf(fabsf(a), fabsf(b))); }
    if (nf) atomicOr(fl, 1u); atomicMax(fl + 1, __float_as_uint(mx));
}
#define DBG(buf, slot) do { if ((slot) == MK_RPT) dbg_scan(F, buf, slot); } while (0)
#else
#define DBG(buf, slot) do { } while (0)
#endif
constexpr int PAR_OFF = 141312;
__device__ __forceinline__ void prep_params(Frame& F, int h) {
    LAS float* PAR = (LAS float*)(F.lds + PAR_OFF); const int t = F.tid, which = t >> 6, k = t & 63, col = h * 64 + k;
    float v;
    switch (which) { case 0: v = F.in[I_MU][C_R + col]; break; case 1: v = F.in[I_MU][C_K + col]; break; case 2: v = F.in[I_MU][C_V + col]; break; case 3: v = F.in[I_W0][col]; break;
                     case 4: v = F.in[I_A0][col]; break; case 5: v = F.in[I_KK][col]; break; case 6: v = F.in[I_KA][col]; break; default: v = F.in[I_RK][col]; break; }
    PAR[which * 64 + k] = v;
}
__device__ __forceinline__ void prep_item(Frame& F, const Bufs& B, int item) {
    const int tid = F.tid, lane = F.lane, wave = F.wave;
    const int bh = item >> 6, ch = item & 63, b = bh >> 4, h = bh & 15;
    const size_t tok0 = (size_t)b * SEQ + ch * 64;
    const bf16_t* P = (const bf16_t*)(F.ws + WS_P); const bf16_t* LA = (const bf16_t*)(F.ws + WS_LA);
    LAS unsigned char* lds = F.lds;
    LAS float* LDf = (LAS float*)(lds + 8 * MB);
    LAS float* AF = (LAS float*)(lds + 10 * MB);
    LAS float* SEG = (LAS float*)(lds + 12 * MB);
    const int ti = tid >> 3, c8 = (tid & 7) * 8, col = h * 64 + c8;
    u32x4 cr, ck, cv, qr_ = (u32x4){0u, 0u, 0u, 0u}, qk_ = qr_, qv_ = qr_;
    { const bf16_t* pr = P + (tok0 + ti) * IN_COLS; const bool hp = (ch * 64 + ti) > 0;
      cr = *(const u32x4*)(pr + C_R + col); ck = *(const u32x4*)(pr + C_K + col); cv = *(const u32x4*)(pr + C_V + col);
      if (hp) { qr_ = *(const u32x4*)(pr - IN_COLS + C_R + col); qk_ = *(const u32x4*)(pr - IN_COLS + C_K + col); qv_ = *(const u32x4*)(pr - IN_COLS + C_V + col); } }
    {
        const int which = wave >> 2, tp = wave & 3;
        const bf16_t* Ar = LA + (tok0 + tp * 16 + (lane & 15)) * LAW + which * 128 + (lane >> 4) * 8;
        const bf16_t* Wt = (const bf16_t*)(F.ws + (which ? WS_WICLR : WS_WDEC)) + (size_t)(h * 64 + (lane & 15)) * 128 + (lane >> 4) * 8;
        bf16x8 bfr[3];
#pragma unroll
        for (int ks = 0; ks < 3; ++ks) bfr[ks] = *(const bf16x8*)(Ar + ks * 32);
        LAS float* dst = which ? AF : LDf;
#pragma unroll
        for (int tq = 0; tq < 4; ++tq) {
            f32x4 acc = (f32x4){0.f, 0.f, 0.f, 0.f};
#pragma unroll
            for (int ks = 0; ks < 3; ++ks) { const bf16x8 afr = *(const bf16x8*)(Wt + (size_t)tq * 16 * 128 + ks * 32); acc = __builtin_amdgcn_mfma_f32_16x16x32_bf16(afr, bfr[ks], acc, 0, 0, 0); }
            *(LAS f32x4*)(dst + (tp * 16 + (lane & 15)) * FP + tq * 16 + 4 * (lane >> 4)) = acc;
        }
    }
    RK_BAR();
    float r[8], kx[8], v[8], ld[8], a[8];
    {
        const LAS float* PAR = (const LAS float*)(lds + PAR_OFF) + c8;
        float pm[8];
#define LDP8(dst, src) do { const f32x4 x0_ = *(const LAS f32x4*)(src), x1_ = *(const LAS f32x4*)((src) + 4); dst[0] = x0_[0]; dst[1] = x0_[1]; dst[2] = x0_[2]; dst[3] = x0_[3]; dst[4] = x1_[0]; dst[5] = x1_[1]; dst[6] = x1_[2]; dst[7] = x1_[3]; } while (0)
        LDP8(pm, PAR + 0 * 64);
#pragma unroll
        for (int j = 0; j < 4; ++j) { const float c0 = bflo(cr[j]), c1 = bfhi(cr[j]); r[2 * j] = c0 + (bflo(qr_[j]) - c0) * pm[2 * j]; r[2 * j + 1] = c1 + (bfhi(qr_[j]) - c1) * pm[2 * j + 1]; }
        LDP8(pm, PAR + 1 * 64);
#pragma unroll
        for (int j = 0; j < 4; ++j) { const float c0 = bflo(ck[j]), c1 = bfhi(ck[j]); kx[2 * j] = c0 + (bflo(qk_[j]) - c0) * pm[2 * j]; kx[2 * j + 1] = c1 + (bfhi(qk_[j]) - c1) * pm[2 * j + 1]; }
        LDP8(pm, PAR + 2 * 64);
#pragma unroll
        for (int j = 0; j < 4; ++j) { const float c0 = bflo(cv[j]), c1 = bfhi(cv[j]); v[2 * j] = c0 + (bflo(qv_[j]) - c0) * pm[2 * j]; v[2 * j + 1] = c1 + (bfhi(qv_[j]) - c1) * pm[2 * j + 1]; }
        float lf[8], af[8];
        LDP8(pm, PAR + 3 * 64); LDP8(lf, LDf + ti * FP + c8);
#pragma unroll
        for (int j = 0; j < 8; ++j) { const float y = -(lf[j] + pm[j]); const float sp = fmaxf(y, 0.f) + __logf(1.f + __expf(-fabsf(y))); ld[j] = -__expf(-sp - 0.5f); }
        LDP8(pm, PAR + 4 * 64); LDP8(af, AF + ti * FP + c8);
#pragma unroll
        for (int j = 0; j < 8; ++j) a[j] = fast_sigmoid(af[j] + pm[j]);
#pragma unroll
        for (int j = 0; j < 8; ++j) LDf[ti * FP + c8 + j] = ld[j];
    }
    RK_BAR();
    {
        const int k = tid & 63, seg = tid >> 6; float run = 0.f;
#pragma unroll
        for (int j = 0; j < 8; ++j) { run += LDf[(seg * 8 + j) * FP + k]; LDf[(seg * 8 + j) * FP + k] = run; }
        SEG[seg * 64 + k] = run;
    }
    RK_BAR();
    {
        float L[8], LC[8];
        LDP8(L, LDf + ti * FP + c8);
#pragma unroll
        for (int j = 0; j < 8; ++j) LC[j] = 0.f;
#pragma unroll
        for (int s2 = 0; s2 < 8; ++s2) { float sv[8]; LDP8(sv, SEG + s2 * 64 + c8);
#pragma unroll
            for (int j = 0; j < 8; ++j) { LC[j] += sv[j]; if (s2 < (ti >> 3)) L[j] += sv[j]; } }
        const LAS float* PAR = (const LAS float*)(lds + PAR_OFF) + c8;
        float kk[8], km[8], ss = 0.f, bon = 0.f, p5[8], p6[8], p7[8];
        LDP8(p5, PAR + 5 * 64); LDP8(p6, PAR + 6 * 64); LDP8(p7, PAR + 7 * 64);
#pragma unroll
        for (int j = 0; j < 8; ++j) { kk[j] = kx[j] * p5[j]; ss += kk[j] * kk[j]; km[j] = kx[j] * (1.f + (a[j] - 1.f) * p6[j]); bon += r[j] * km[j] * p7[j]; }
        ss += __shfl_xor(ss, 1); ss += __shfl_xor(ss, 2); ss += __shfl_xor(ss, 4);
        bon += __shfl_xor(bon, 1); bon += __shfl_xor(bon, 2); bon += __shfl_xor(bon, 4);
        const float inv = 1.f / fmaxf(sqrtf(ss), 1e-12f);
        if ((tid & 7) == 0) B.BON[(tok0 + ti) * RH + h] = bon;
        if (ti == 63) {
#pragma unroll
            for (int j = 0; j < 8; ++j) B.PC[(size_t)item * 64 + c8 + j] = __expf(LC[j]);
        }
        float eL[8], eLx[8], eN[8], eC[8];
#pragma unroll
        for (int j = 0; j < 8; ++j) { kk[j] *= inv; eL[j] = __expf(L[j]); eLx[j] = __expf(L[j] - ld[j]); eN[j] = __expf(-L[j]); eC[j] = __expf(LC[j] - L[j]); }
#define PK8(x) (u32x4){cvt_pk_bf16(x[0], x[1]), cvt_pk_bf16(x[2], x[3]), cvt_pk_bf16(x[4], x[5]), cvt_pk_bf16(x[6], x[7])}
#define ST_TOK(buf, x) *(LAS u32x4*)(mbuf(lds, buf) + ti * (LDM * 2) + c8 * 2) = PK8(x)
#define ST_CH(buf, x) do { _Pragma("unroll") for (int j = 0; j < 8; ++j) *(LAS bf16_t*)(mbuf(lds, buf) + (c8 + j) * (LDM * 2) + ti * 2) = f2bf(x[j]); } while (0)
#define FENCE() asm volatile("" ::: "memory")
        { float x[8];
#pragma unroll
          for (int j = 0; j < 8; ++j) x[j] = -kk[j] * eLx[j];
          ST_TOK(0, x); ST_CH(4, x); } FENCE();
        { float x[8];
#pragma unroll
          for (int j = 0; j < 8; ++j) x[j] = r[j] * eL[j];
          ST_TOK(1, x); } FENCE();
        { float x[8];
#pragma unroll
          for (int j = 0; j < 8; ++j) x[j] = MK_NODELTA ? 0.f : kk[j] * a[j] * eN[j];
          ST_TOK(2, x); } FENCE();
        { float x[8];
#pragma unroll
          for (int j = 0; j < 8; ++j) x[j] = km[j] * eN[j];
          ST_TOK(3, x); } FENCE();
        { float x[8];
#pragma unroll
          for (int j = 0; j < 8; ++j) x[j] = MK_NODELTA ? 0.f : kk[j] * a[j] * eC[j];
          ST_CH(5, x); } FENCE();
        { float x[8];
#pragma unroll
          for (int j = 0; j < 8; ++j) x[j] = km[j] * eC[j];
          ST_CH(6, x); } FENCE();
        ST_CH(7, v);
#undef PK8
#undef ST_TOK
#undef ST_CH
#undef FENCE
    }
    RK_BAR();
    DBG(0, 8); DBG(1, 9); DBG(2, 10); DBG(3, 11); DBG(4, 12); DBG(5, 13); DBG(6, 14); DBG(7, 15);
#if MK_R2SKIP == 1
    return;
#endif
    const f32x4 Z = (f32x4){0.f, 0.f, 0.f, 0.f};
    {
        const int mi = wave >> 1;
        const LAS char* Bp = mbuf(lds, (mi < 2) ? 0 : 1); const LAS char* Aq = mbuf(lds, (mi & 1) ? 3 : 2);
        LAS char* dst = mbuf(lds, mi == 0 ? 8 : 9 + mi);
#pragma unroll 1
        for (int tt = 0; tt < 2; ++tt) { const int tp = 2 * (wave & 1) + tt;
#pragma unroll 1
            for (int tq = 0; tq < 4; ++tq) {
                f32x4 acc = Z;
                if (tq <= tp) acc = tile64(Aq, Bp, tq, tp, lane, acc);
                const int pi = tp * 16 + (lane & 15), qj = tq * 16 + 4 * (lane >> 4);
#pragma unroll
                for (int e = 0; e < 4; ++e) { const bool keep = (mi < 2) ? (qj + e < pi) : (qj + e <= pi); if (!keep) acc[e] = 0.f; }
                st_pq(dst, tq, tp, lane, acc);
            }
        }
    }
    for (int e = tid; e < MB / 16; e += NWAVES * 64) *(LAS u32x4*)(mbuf(lds, 9) + e * 16) = (u32x4){0u, 0u, 0u, 0u};
    RK_BAR();
    for (int e = tid; e < MB / 16; e += NWAVES * 64) { const u32x4 z4 = (u32x4){0u, 0u, 0u, 0u};
        *(LAS u32x4*)(mbuf(lds, 0) + e * 16) = z4; *(LAS u32x4*)(mbuf(lds, 2) + e * 16) = z4; *(LAS u32x4*)(mbuf(lds, 3) + e * 16) = z4; *(LAS u32x4*)(mbuf(lds, 14) + e * 16) = z4; }
    if (wave == 0) {
        const int blk = lane >> 4, c = lane & 15; float Tc[16];
        const LAS char* Pm = mbuf(lds, 8) + blk * 16 * (LDM * 2) + blk * 32;
#pragma unroll
        for (int i = 0; i < 16; ++i) {
            asm volatile("" ::: "memory");
            const u32x4 m0 = *(const LAS u32x4*)(Pm + i * (LDM * 2)), m1 = *(const LAS u32x4*)(Pm + i * (LDM * 2) + 16);
            float acc = (i == c) ? 1.f : 0.f;
#pragma unroll
            for (int j = 0; j < i; ++j) { const unsigned w = (j < 8) ? m0[(j >> 1) & 3] : m1[(j >> 1) & 3]; const float mij = (j & 1) ? bfhi(w) : bflo(w); acc = fmaf(mij, Tc[j], acc); }
            Tc[i] = acc;
        }
#pragma unroll
        for (int i = 0; i < 16; ++i) *(LAS bf16_t*)(mbuf(lds, 9) + (blk * 16 + i) * (LDM * 2) + (blk * 16 + c) * 2) = f2bf(Tc[i]);
    } else if (wave >= 4) {
        const int tp = wave & 3;
#pragma unroll
        for (int tq = 0; tq < 4; ++tq) { const f32x4 acc = tile64(mbuf(lds, 10), mbuf(lds, 7), tq, tp, lane, Z); st_pq(mbuf(lds, 13), tq, tp, lane, acc); }
    }
    RK_BAR();
#pragma unroll 1
    for (int ab = 0; ab < 4; ++ab) {
        const int which = wave >> 2, tp = wave & 3;
        {
            f32x4 acc = ld_pq(mbuf(lds, which ? 13 : 4), ab, tp, lane);
            if (ab > 0) acc = tile64(mbuf(lds, 8), mbuf(lds, which ? 3 : 2), ab, tp, lane, acc);
            st_pq(mbuf(lds, which ? 0 : 14), ab, tp, lane, acc);
        }
        RK_BAR();
        {
            const f32x4 acc = tile64(mbuf(lds, 9), mbuf(lds, which ? 0 : 14), ab, tp, lane, Z);
            st_pq(mbuf(lds, which ? 3 : 2), ab, tp, lane, acc);
#if MK_CHECK
            if (item == (3 * 16 + 15) * 64 && which) gst_pq((bf16_t*)(F.ws + WS_CTL + 32768), ab, tp, lane, acc);
#endif
        }
        RK_BAR();
    }
    DBG(8, 24); DBG(9, 25);
    {
        const int oi = wave >> 1; const size_t ob = (size_t)item * 4096;
#pragma unroll 1
        for (int tt = 0; tt < 2; ++tt) { const int tp = 2 * (wave & 1) + tt;
#pragma unroll 1
            for (int tq = 0; tq < 4; ++tq) {
                if (oi == 0) {
                    gst_pq(B.G + ob, tq, tp, lane, tile64(mbuf(lds, 2), mbuf(lds, 5), tq, tp, lane, Z));
                } else if (oi == 1) {
                    f32x4 acc = tile64(mbuf(lds, 5), mbuf(lds, 3), tq, tp, lane, Z); acc = tile64(mbuf(lds, 6), mbuf(lds, 7), tq, tp, lane, acc);
                    gst_pq(B.H + ob, tq, tp, lane, acc);
                } else if (oi == 2) {
                    f32x4 acc = ld_pq(mbuf(lds, 1), tq, tp, lane); acc = tile64(mbuf(lds, 2), mbuf(lds, 11), tq, tp, lane, acc);
                    gst_pq(B.Qe + ob, tq, tp, lane, acc);
                } else {
                    f32x4 acc = tile64(mbuf(lds, 3), mbuf(lds, 11), tq, tp, lane, Z); acc = tile64(mbuf(lds, 7), mbuf(lds, 12), tq, tp, lane, acc);
                    gst_pq(B.Yi + ob, tq, tp, lane, acc);
                }
            }
        }
    }
    RK_BAR();
}

__device__ __forceinline__ void scan_unit(const Bufs& B, int bh, int vq, int lane) {
    const int vl = lane & 15, q = lane >> 4, v = vq * 16 + vl;
    f32x4 S[4];
#pragma unroll
    for (int t = 0; t < 4; ++t) S[t] = (f32x4){0.f, 0.f, 0.f, 0.f};
    u32x2 gA[4][2][2], gB[4][2][2]; u32x2 hA[4], hB[4]; f32x4 pA[4], pB[4];
#define RK_LOAD(gfr, hfr, pc, c) do { const size_t it_ = (size_t)(bh * 64 + (c)); const bf16_t* Gp = B.G + it_ * 4096; const bf16_t* Hp = B.H + it_ * 4096; const float* Pp = B.PC + it_ * 64; \
        _Pragma("unroll") for (int t = 0; t < 4; ++t) { \
            _Pragma("unroll") for (int ks = 0; ks < 2; ++ks) _Pragma("unroll") for (int hf = 0; hf < 2; ++hf) gfr[t][ks][hf] = *(const u32x2*)(Gp + (t * 16 + vl) * 64 + 16 * (2 * ks + hf) + 4 * q); \
            hfr[t] = *(const u32x2*)(Hp + v * 64 + t * 16 + 4 * q); pc[t] = *(const f32x4*)(Pp + t * 16 + 4 * q); } } while (0)
#define RK_STEP(gfr, hfr, pc, c, cn) do { \
        u32x2 sb[4]; \
        _Pragma("unroll") for (int t = 0; t < 4; ++t) { sb[t].x = cvt_pk_bf16(S[t][0], S[t][1]); sb[t].y = cvt_pk_bf16(S[t][2], S[t][3]); } \
        { bf16_t* Sp = B.S0 + (size_t)(bh * 64 + (c)) * 4096 + v * 64 + 4 * q; \
          _Pragma("unroll") for (int t = 0; t < 4; ++t) *(u32x2*)(Sp + t * 16) = sb[t]; } \
        bf16x8 bfr[2]; \
        { u32x4 w0 = {sb[0].x, sb[0].y, sb[1].x, sb[1].y}, w1 = {sb[2].x, sb[2].y, sb[3].x, sb[3].y}; bfr[0] = *reinterpret_cast<bf16x8*>(&w0); bfr[1] = *reinterpret_cast<bf16x8*>(&w1); } \
        f32x4 acc[4]; \
        _Pragma("unroll") for (int t = 0; t < 4; ++t) { const f32x4 hv = (f32x4){bflo(hfr[t].x), bfhi(hfr[t].x), bflo(hfr[t].y), bfhi(hfr[t].y)}; acc[t] = S[t] * pc[t] + hv; } \
        bf16x8 afr[4][2]; \
        _Pragma("unroll") for (int t = 0; t < 4; ++t) _Pragma("unroll") for (int ks = 0; ks < 2; ++ks) { u32x4 w = {gfr[t][ks][0].x, gfr[t][ks][0].y, gfr[t][ks][1].x, gfr[t][ks][1].y}; afr[t][ks] = *reinterpret_cast<bf16x8*>(&w); } \
        if ((cn) < 64) RK_LOAD(gfr, hfr, pc, (cn)); \
        _Pragma("unroll") for (int t = 0; t < 4; ++t) { acc[t] = __builtin_amdgcn_mfma_f32_16x16x32_bf16(afr[t][0], bfr[0], acc[t], 0, 0, 0); acc[t] = __builtin_amdgcn_mfma_f32_16x16x32_bf16(afr[t][1], bfr[1], acc[t], 0, 0, 0); } \
        _Pragma("unroll") for (int t = 0; t < 4; ++t) S[t] = acc[t]; } while (0)
    RK_LOAD(gA, hA, pA, 0); RK_LOAD(gB, hB, pB, 1);
#pragma unroll 1
    for (int c = 0; c < 64; c += 2) {
        RK_STEP(gA, hA, pA, c, c + 2);
        RK_STEP(gB, hB, pB, c + 1, c + 3);
    }
#undef RK_STEP
#undef RK_LOAD
}

__device__ __forceinline__ void out_item(Frame& F, const Bufs& B, int item, int tn) {
    const int lane = F.lane, il = lane & 15, q = lane >> 4;
    const int bh = item >> 6, ch = item & 63, b = bh >> 4, h = bh & 15;
    const size_t tok0 = (size_t)b * SEQ + ch * 64, row = tok0 + tn * 16 + il;
    const bf16_t* Qp = B.Qe + (size_t)item * 4096 + (tn * 16 + il) * 64 + q * 8;
    const bf16_t* Sp = B.S0 + (size_t)item * 4096 + il * 64 + q * 8;
    const bf16x8 b0 = *(const bf16x8*)Qp, b1 = *(const bf16x8*)(Qp + 32);
    const bf16_t* LAr = (const bf16_t*)(F.ws + WS_LA) + row * LAW + 256 + q * 8;
    const bf16_t* Wg = (const bf16_t*)(F.ws + WS_WGATE) + (size_t)(h * 64 + il) * 256 + q * 8;
    bf16x8 gb[8];
#pragma unroll
    for (int ks = 0; ks < 8; ++ks) gb[ks] = *(const bf16x8*)(LAr + ks * 32);
    f32x4 y[4], g[4];
#pragma unroll
    for (int t = 0; t < 4; ++t) {
        const u32x2 yi = *(const u32x2*)(B.Yi + (size_t)item * 4096 + (tn * 16 + il) * 64 + t * 16 + 4 * q);
        f32x4 acc = (f32x4){bflo(yi.x), bfhi(yi.x), bflo(yi.y), bfhi(yi.y)};
        const bf16x8 a0 = *(const bf16x8*)(Sp + t * 16 * 64), a1 = *(const bf16x8*)(Sp + t * 16 * 64 + 32);
        acc = __builtin_amdgcn_mfma_f32_16x16x32_bf16(a0, b0, acc, 0, 0, 0); y[t] = __builtin_amdgcn_mfma_f32_16x16x32_bf16(a1, b1, acc, 0, 0, 0);
        f32x4 ga = (f32x4){0.f, 0.f, 0.f, 0.f};
#pragma unroll
        for (int ks = 0; ks < 8; ++ks) { const bf16x8 wa = *(const bf16x8*)(Wg + (size_t)t * 16 * 256 + ks * 32); ga = __builtin_amdgcn_mfma_f32_16x16x32_bf16(wa, gb[ks], ga, 0, 0, 0); }
        g[t] = ga;
    }
    float s = 0.f;
#pragma unroll
    for (int t = 0; t < 4; ++t) s += (y[t][0] + y[t][1]) + (y[t][2] + y[t][3]);
    s += __shfl_xor(s, 16); s += __shfl_xor(s, 32);
    const float mean = s * (1.f / 64.f); float d2 = 0.f;
#pragma unroll
    for (int t = 0; t < 4; ++t)
#pragma unroll
        for (int e = 0; e < 4; ++e) { const float d = y[t][e] - mean; d2 += d * d; }
    d2 += __shfl_xor(d2, 16); d2 += __shfl_xor(d2, 32);
    const float rstd = rsqrtf(d2 * (1.f / 64.f) + GN_EPS);
    const float bon = B.BON[row * RH + h];
    const bf16_t* pr = (const bf16_t*)(F.ws + WS_P) + row * IN_COLS + C_V + h * 64; const bool hp = (ch * 64 + tn * 16 + il) > 0;
    bf16_t* Yo = (bf16_t*)(F.ws + WS_YCAT) + row * DM + h * 64;
#pragma unroll
    for (int t = 0; t < 4; ++t) {
        const int c0 = t * 16 + 4 * q; const u32x2 cv = *(const u32x2*)(pr + c0); u32x2 qv = (u32x2){0u, 0u}; if (hp) qv = *(const u32x2*)(pr - IN_COLS + c0);
        const f32x4 mu = *(const f32x4*)(F.in[I_MU] + C_V + h * 64 + c0), lg = *(const f32x4*)(F.in[I_LNG] + h * 64 + c0), lb = *(const f32x4*)(F.in[I_LNB] + h * 64 + c0);
        f32x4 vv = (f32x4){bflo(cv.x), bfhi(cv.x), bflo(cv.y), bfhi(cv.y)}; const f32x4 pv = (f32x4){bflo(qv.x), bfhi(qv.x), bflo(qv.y), bfhi(qv.y)};
        vv = vv + (pv - vv) * mu;
        f32x4 o;
#pragma unroll
        for (int e = 0; e < 4; ++e) o[e] = ((y[t][e] - mean) * rstd * lg[e] + lb[e] + bon * vv[e]) * g[t][e];
        u32x2 w; w.x = cvt_pk_bf16(o[0], o[1]); w.y = cvt_pk_bf16(o[2], o[3]);
        *(u32x2*)(Yo + c0) = w;
    }
}
}
constexpr int N_PHASES = 13;
struct Args { const void* in[30]; float* out; unsigned char* ws; int ph_lo, ph_hi, li, pad; };
__global__ void __launch_bounds__(NWAVES * 64, 2) mk_fwd(Args args) {
    extern __shared__ __attribute__((aligned(16))) unsigned char lds[];
    Frame F;
    F.lds = (LAS unsigned char*)lds;
    F.MISC = (volatile LAS unsigned*)(F.lds + MISC_OFF);
    F.tid = threadIdx.x; F.lane = F.tid & 63; F.wave = __builtin_amdgcn_readfirstlane(F.tid >> 6);
    F.G = gridDim.x; { const int bx = blockIdx.x; F.vcu = (F.G % 8 == 0) ? (bx % 8) * (F.G / 8) + bx / 8 : bx; }
    F.ws = args.ws; F.out = args.out; F.ctl = (gu32*)(args.ws + WS_CTL);
#pragma unroll
    for (int i = 0; i < 30; ++i) F.in[i] = (const float*)args.in[i];
    for (int u = F.tid; u < (LDS_BYTES - LDSCTL_OFF) / 4; u += NWAVES * 64) ((LAS unsigned*)(F.lds + LDSCTL_OFF))[u] = 0u;
    __syncthreads();
    XcdBarrier bar; bar.bar = (unsigned*)(F.ctl + CW_BAR); bar.x = 0; bar.st = nullptr;
#if MK_ONE_LAUNCH
    bar = xcd_barrier_post((unsigned*)(F.ctl + CW_BAR), F.MISC + 8);
#define GRID_BAR() xcd_barrier(bar)
#else
#define GRID_BAR() do { } while (0)
#endif
    const int lo = args.ph_lo, hi = args.ph_hi;
#ifndef P4SEL
#define P4SEL 31
#endif
#ifndef MK_FLIP
#define MK_FLIP 0
#endif
#ifndef PH_MASK
#define PH_MASK 0x1fff
#endif
#define IN(k) (((PH_MASK >> (k)) & 1) && lo <= (k) && (k) < hi)
#ifndef MK_TIME
#define MK_TIME (-1)
#endif
#define STAMP(k) do { if (MK_TIME >= 0 && blockIdx.x == 0 && F.tid == 0) ((unsigned long long*)(F.ws + WS_CTL + 49152))[(k)] = __builtin_amdgcn_s_memrealtime(); } while (0)
#define SEAM(k) do { if (IN(k) && (IN((k) + 1) || MK_TIME >= 0)) GRID_BAR(); STAMP((k) + 1); } while (0)
    float* LD = args.out; bf16_t* Ab = (bf16_t*)((char*)args.out + 64 * MiB); bf16_t* Gb = (bf16_t*)((char*)args.out + 96 * MiB);

    STAMP(0);
    if (IN(0)) { phase_mod(F); SEAM(0); }
    if (IN(1)) { phase_weights(F, false, F.vcu * NWAVES + F.wave, F.G * NWAVES); phase_convcopy(F); phase_hprep(F); SEAM(1); }
    if (IN(2)) {
        pg8::Gemm g{(const bf16_t*)(F.ws + WS_H), (const bf16_t*)(F.ws + WS_WIN), TOK, IN_COLS, DM, DM, DM};
        pg8::StaticOrder S; S.init(TOK, IN_COLS, F.G, (int)blockIdx.x);
        EpiOut<0> E{(bf16_t*)(F.ws + WS_P), nullptr, IN_COLS, nullptr, 1.f, nullptr, nullptr};
        pg8::gemm_phase(F.lds + RING_OFF, g, S, E);
        {
            const int nfull = (S.nwg / F.G) * F.G, nbusy = S.nwg - nfull;
            if (nbusy == 0) phase_weights(F, true, F.vcu * NWAVES + F.wave, F.G * NWAVES);
            else if ((int)blockIdx.x >= nbusy) phase_weights(F, true, ((int)blockIdx.x - nbusy) * NWAVES + F.wave, (F.G - nbusy) * NWAVES);
        }
        SEAM(2);
    }
    if (IN(3)) { phase_tokprep(F); SEAM(3); }
    if (IN(4)) {
#pragma unroll 1
        for (int gi = 0; gi < 2; ++gi) {
            pg8::Gemm g; EpiMulti E;
            const bf16_t* Pb = (const bf16_t*)(F.ws + WS_P);
            if (gi == 0)      { g = pg8::Gemm{Pb + C_QL, (const bf16_t*)(F.ws + WS_WQ), TOK, QW, QLR, IN_COLS, QLR};
                                E = EpiMulti{1, (bf16_t*)(F.ws + WS_Q), nullptr, QW, (const float*)(F.ws + WS_RSTDQ), 0.07216878364870322f * 1.4426950408889634f, nullptr}; }
            else              { g = pg8::Gemm{Pb + C_KVL, (const bf16_t*)(F.ws + WS_WKV), TOK, KVW, KVLR, IN_COLS, KVLR};
                                E = EpiMulti{1, (bf16_t*)(F.ws + WS_KV), nullptr, KVW, (const float*)(F.ws + WS_RSTDKV), 1.f, nullptr}; }
            pg8::StaticOrder S; S.init(g.M, g.N, F.G, (int)blockIdx.x);
            pg8::gemm_phase(F.lds + RING_OFF, g, S, E);
        }
        SEAM(4);
    }
    rk::Bufs RB{(bf16_t*)args.out, (bf16_t*)((char*)args.out + 32 * MiB), (bf16_t*)((char*)args.out + 64 * MiB), (bf16_t*)((char*)args.out + 96 * MiB),
                (bf16_t*)(F.ws + WS_H + 16 * MiB), (float*)(F.ws + WS_H + 48 * MiB), (float*)(F.ws + WS_H + 49 * MiB)};
    if (IN(5)) {
        { int cur_bh = -1;
#pragma unroll 1
          for (int it = 0;; ++it) { const int item = (it & 15) + 16 * (F.vcu + (it >> 4) * F.G); if (item >= 4096) break;
              if ((item >> 6) != cur_bh) { cur_bh = item >> 6; __syncthreads(); rk::prep_params(F, cur_bh & 15); __syncthreads(); }
              rk::prep_item(F, RB, item); } }
        SEAM(5);
    }
    if (IN(6)) {
        if (F.wave == 0) for (int u = F.vcu; u < 256; u += F.G) rk::scan_unit(RB, u >> 2, u & 3, F.lane);
        SEAM(6);
    }
    if (IN(7)) {
        for (int task = F.vcu * NWAVES + F.wave; task < 16384; task += F.G * NWAVES) rk::out_item(F, RB, task >> 2, task & 3);
        __syncthreads();
        for (int u = F.vcu; u < 256; u += F.G) {
            const int bh = u >> 3, s = u & 7, b = bh >> 3, h = bh & 7;
#pragma unroll 1
            for (int it2 = 0; it2 < 2; ++it2)
                att::attn_unit(b, h, it2 ? 15 - s : s, (const bf16_t*)(F.ws + WS_Q), (const bf16_t*)(F.ws + WS_KV), (const bf16_t*)(F.ws + WS_KR), (const f32x2*)(F.ws + WS_CS), (bf16_t*)(F.ws + WS_YCAT), (char*)lds);
        }
        SEAM(7);
    }
    if (IN(8)) {
        pg8::Gemm g{(const bf16_t*)(F.ws + WS_YCAT), (const bf16_t*)(F.ws + WS_WOUT), TOK, DM, DM, DM, DM};
        pg8::StaticOrder S; S.init(TOK, DM, F.G, (int)blockIdx.x);
        EpiOut<4> E{(bf16_t*)(F.ws + WS_O1), nullptr, DM, nullptr, 1.f, nullptr, (float*)(F.ws + WS_SSQ1)};
        pg8::gemm_phase(F.lds + RING_OFF, g, S, E);
        SEAM(8);
    }
    if (IN(9)) { phase_mid(F); SEAM(9); }
    if (IN(10)) {
        pg8::Gemm g{(const bf16_t*)(F.ws + WS_H), (const bf16_t*)(F.ws + WS_WUP), TOK, UPW, DM, DM, DM};
        pg8::StaticOrder S; S.init(TOK, UPW, F.G, (int)blockIdx.x); S.flip = MK_FLIP;
        EpiConv E{(bf16_t*)(F.ws + WS_ACT), (const float*)(F.ws + WS_CONV), (const float*)(F.ws + WS_CONV) + 3 * UPW, (float*)(F.ws + WS_HEAD), (float*)(F.ws + WS_TAIL), (LAS float*)(F.lds + TB_OFF)};
        pg8::gemm_phase(F.lds + RING_OFF, g, S, E);
        SEAM(10);
    }
    if (IN(11)) {
        pg8::Gemm g{(const bf16_t*)(F.ws + WS_ACT), (const bf16_t*)(F.ws + WS_WDOWN), TOK, DM, DFF, DFF, DFF};
        pg8::StaticOrder S; S.init(TOK, DM, F.G, (int)blockIdx.x);
        { pg8::Unit u; int last = -1; for (int i = 0; S.next(i, u); ++i) if (u.pm != last) { fixup_panel(F, u.pm); last = u.pm; }
          VM_WAIT(); __syncthreads();
          if (F.tid == 0) { __builtin_amdgcn_fence(__ATOMIC_ACQUIRE, "agent"); VM_WAIT(); }
          __syncthreads(); }
        EpiOut<4> E{(bf16_t*)(F.ws + WS_O2), nullptr, DM, nullptr, 1.f, nullptr, (float*)(F.ws + WS_SSQ2)};
        pg8::gemm_phase(F.lds + RING_OFF, g, S, E);
        SEAM(11);
    }
    if (IN(12)) { phase_final(F);
    }
#if MK_ONE_LAUNCH
    if (MK_TIME >= 0) { GRID_BAR();
        if (MK_R2SKIP || (PH_MASK != 0x1fff)) for (size_t i = (size_t)blockIdx.x * 512 + F.tid + 1; i < (size_t)TOK * DM; i += (size_t)F.G * 512) args.out[i] = 0.f;
        if (blockIdx.x == 0 && F.tid == 0) { const unsigned long long* ts = (const unsigned long long*)(F.ws + WS_CTL + 49152);
            const float us_ = (float)(ts[MK_TIME + 1] - ts[MK_TIME]) * 0.01f; args.out[0] = __expf(rintf(__logf(fmaxf(us_, 1.f)) * (1.f / 0.18232f)) * 0.18232f); } }
#endif
#undef IN
#undef SEAM
}

#if MK_CHECK
#ifndef MK_RPT
#define MK_RPT 0
#endif
__global__ void chk_scan(const bf16_t* p, size_t n, unsigned* flag) {
    float mx = 0.f; bool nf = false;
    for (size_t i = blockIdx.x * 256 + threadIdx.x; i < n; i += (size_t)gridDim.x * 256) { const float v = bf2f(p[i]); if (!(fabsf(v) <= 3e38f)) nf = true; else mx = fmaxf(mx, fabsf(v)); }
    if (nf) atomicOr(flag, 1u);
    atomicMax(flag + 1, __float_as_uint(mx));
}
__global__ void chk_apply(Args a) {
    unsigned* fl = (unsigned*)(a.ws + WS_CTL) + 8;
    for (size_t i = blockIdx.x * 256 + threadIdx.x; i < (size_t)TOK * DM; i += (size_t)gridDim.x * 256) a.out[i] = 0.f;
    __syncthreads();
    if (blockIdx.x == 0 && threadIdx.x == 0) {
        const unsigned s = MK_RPT; const bool nf = fl[2 * s] != 0u; const float mx = __uint_as_float(fl[2 * s + 1]);
        int dg = (int)floorf(log10f(fmaxf(mx, 1e-30f))) + 5; if (dg < 0) dg = 0; if (dg > 9) dg = 9;
        a.out[1] = 1000.f * (float)(10 * (nf ? 9 : 1) + dg);
    }
}
#endif
#if MK_CHECK
__global__ void __launch_bounds__(64) chk_rwkv(Args a, int b, int h, int NTOK) {
    __shared__ float vec[5][64];
    const float* const* in = (const float* const*)a.in; unsigned char* ws = a.ws; unsigned* fl = (unsigned*)(ws + WS_CTL) + 8 + 60;
    const bf16_t* P = (const bf16_t*)(ws + WS_P); const bf16_t* Y = (const bf16_t*)(ws + WS_YCAT);
    const int lane = threadIdx.x, col = h * 64 + lane;
    float S[64];
#pragma unroll
    for (int k = 0; k < 64; ++k) S[k] = 0.f;
    float maxrel = 0.f; int first = 999;
    for (int t = 0; t < NTOK; ++t) {
        const size_t row = (size_t)b * SEQ + t; const bf16_t* pr = P + row * IN_COLS; const bf16_t* pp = pr - IN_COLS; const bool hp = t > 0;
        float r = bf2f(pr[C_R + col]), k = bf2f(pr[C_K + col]), v = bf2f(pr[C_V + col]);
        r += ((hp ? bf2f(pp[C_R + col]) : 0.f) - r) * in[I_MU][C_R + col]; k += ((hp ? bf2f(pp[C_K + col]) : 0.f) - k) * in[I_MU][C_K + col]; v += ((hp ? bf2f(pp[C_V + col]) : 0.f) - v) * in[I_MU][C_V + col];
        float sw = 0.f, sa = 0.f, sg = 0.f;
        for (int l = 0; l < 96; ++l) { float x = bf2f(pr[C_WD + l]); x += ((hp ? bf2f(pp[C_WD + l]) : 0.f) - x) * in[I_MU][C_WD + l]; sw += tanhf(x) * in[I_WDEC][(size_t)l * RW + col];
                                       float x2 = bf2f(pr[C_AD + l]); x2 += ((hp ? bf2f(pp[C_AD + l]) : 0.f) - x2) * in[I_MU][C_AD + l]; sa += x2 * in[I_WICLR][(size_t)l * RW + col]; }
        for (int l = 0; l < 256; ++l) { float x = bf2f(pr[C_GD + l]); x += ((hp ? bf2f(pp[C_GD + l]) : 0.f) - x) * in[I_MU][C_GD + l]; sg += 1.f / (1.f + expf(-x)) * in[I_WGATE][(size_t)l * RW + col]; }
        const float z = in[I_W0][col] + sw; const float w = expf(-expf(-log1pf(expf(-z)) - 0.5f)); const float aa = 1.f / (1.f + expf(-(in[I_A0][col] + sa)));
        float kkx = k * in[I_KK][col]; float ss = kkx * kkx;
        for (int o = 1; o < 64; o <<= 1) ss += __shfl_xor(ss, o);
        const float kk = kkx / fmaxf(sqrtf(ss), 1e-12f); const float km = k * (1.f + (aa - 1.f) * in[I_KA][col]);
        float bon = r * km * in[I_RK][col];
        for (int o = 1; o < 64; o <<= 1) bon += __shfl_xor(bon, o);
        __syncthreads();
        vec[0][lane] = r; vec[1][lane] = w; vec[2][lane] = km; vec[3][lane] = -kk; vec[4][lane] = MK_NODELTA ? 0.f : kk * aa;
        __syncthreads();
        float sac = 0.f;
#pragma unroll
        for (int kq = 0; kq < 64; ++kq) sac += S[kq] * vec[3][kq];
        if (t < 64) { const bf16_t* dbgb = (const bf16_t*)(ws + WS_CTL + 32768); const float got = bf2f(dbgb[lane * 64 + t]); float e2 = (got - sac) * (got - sac), s2 = sac * sac;
            for (int o = 1; o < 64; o <<= 1) { e2 += __shfl_xor(e2, o); s2 += __shfl_xor(s2, o); }
            const float re = sqrtf(e2 / fmaxf(s2, 1e-20f)); if (lane == 0) { float* ff = (float*)fl; if (re > ff[10]) { ff[10] = re; fl[11] = (unsigned)t; } if (t == 1) ff[12] = re; if (t == 8) ff[13] = re; if (t == 40) ff[14] = re; } }
        float y = 0.f;
#pragma unroll
        for (int kq = 0; kq < 64; ++kq) { S[kq] = S[kq] * vec[1][kq] + sac * vec[4][kq] + v * vec[2][kq]; y += S[kq] * vec[0][kq]; }
        float mean = y; for (int o = 1; o < 64; o <<= 1) mean += __shfl_xor(mean, o); mean *= (1.f / 64.f);
        float var = (y - mean) * (y - mean); for (int o = 1; o < 64; o <<= 1) var += __shfl_xor(var, o); var *= (1.f / 64.f);
        const float ref = ((y - mean) * rsqrtf(var + GN_EPS) * in[I_LNG][col] + in[I_LNB][col] + bon * v) * sg;
        const float got = bf2f(Y[row * DM + col]);
        float err = fabsf(got - ref); float sc = fabsf(ref); for (int o = 1; o < 64; o <<= 1) { err = fmaxf(err, __shfl_xor(err, o)); sc = fmaxf(sc, __shfl_xor(sc, o)); }
        const float rel = err / fmaxf(sc, 1e-6f);
        if ((t & 63) == 63 && t < 64 * 4) {
            const bf16_t* S0b = (const bf16_t*)(ws + WS_H + 16 * MiB) + ((size_t)((b * 16 + h) * 64 + (t >> 6) + 1)) * 4096 + lane * 64;
            float e2 = 0.f, s2 = 0.f;
            for (int kq = 0; kq < 64; ++kq) { const float d = bf2f(S0b[kq]) - S[kq]; e2 += d * d; s2 += S[kq] * S[kq]; }
            for (int o = 1; o < 64; o <<= 1) { e2 += __shfl_xor(e2, o); s2 += __shfl_xor(s2, o); }
            if (lane == 0) ((float*)fl)[2 + (t >> 6)] = sqrtf(e2 / fmaxf(s2, 1e-20f));
        }
        if (rel > 0.06f && first == 999) first = t;
        maxrel = fmaxf(maxrel, rel);
    }
    if (lane == 0) { fl[0] = (unsigned)first; ((float*)fl)[1] = maxrel; }
}
__global__ void chk_apply2(Args a) {
    const unsigned* fl = (const unsigned*)(a.ws + WS_CTL) + 8 + 60;
    for (size_t i = blockIdx.x * 256 + threadIdx.x; i < (size_t)TOK * DM; i += (size_t)gridDim.x * 256) a.out[i] = 0.f;
    __syncthreads();
    if (blockIdx.x == 0 && threadIdx.x == 0) {
        const unsigned first = fl[0]; const float mr = ((const float*)fl)[1];
        if (MK_RPT == 121) { a.out[1] = 1000.f * (float)fl[11]; return; }
        if (MK_RPT >= 120) { a.out[1] = 1000.f * fminf(99.f, rintf(((const float*)fl)[10 + (MK_RPT == 120 ? 0 : MK_RPT - 120)] * 100.f)); return; }
        if (MK_RPT >= 110) { a.out[1] = 1000.f * fminf(99.f, rintf(((const float*)fl)[2 + MK_RPT - 110] * 100.f)); return; }
        unsigned code = MK_RPT == 100 ? (first > 4095u ? 99u : first / 64u) : MK_RPT == 102 ? (first > 4095u ? 99u : first % 64u) : (unsigned)fminf(99.f, mr * 100.f);
        a.out[1] = 1000.f * (float)code;
    }
}
#endif
extern "C" void kernel_launch(void* const* d_in, const int* in_sizes, int n_in, void* d_out, int out_size, void* d_ws, size_t ws_size, hipStream_t stream) {
    static int grid = 0;
    if (grid == 0) {
        if (n_in != 30 || in_sizes[0] != TOK * DM || out_size != TOK * DM || ws_size < WS_END) {
            fprintf(stderr, "kernel_launch: unexpected shapes: n_in %d in0 %d out %d ws %zu (need %zu)\n", n_in, n_in > 0 ? in_sizes[0] : -1, out_size, ws_size, (size_t)WS_END); grid = -1; return; }
        int dev = 0, cus = 0, per_cu = 0;
        if (hipGetDevice(&dev) != hipSuccess || hipDeviceGetAttribute(&cus, hipDeviceAttributeMultiprocessorCount, dev) != hipSuccess) { fprintf(stderr, "kernel_launch: device query failed\n"); grid = -1; return; }
        if (hipFuncSetAttribute((const void*)mk_fwd, hipFuncAttributeMaxDynamicSharedMemorySize, LDS_BYTES) != hipSuccess) { fprintf(stderr, "kernel_launch: hipFuncSetAttribute failed\n"); grid = -1; return; }
        if (hipOccupancyMaxActiveBlocksPerMultiprocessor(&per_cu, (const void*)mk_fwd, NWAVES * 64, LDS_BYTES) != hipSuccess || per_cu < 1) {
            fprintf(stderr, "kernel_launch: occupancy query reports %d blocks per CU\n", per_cu); grid = -1; (void)hipGetLastError(); return; }
        (void)hipGetLastError();
        grid = cus;
    }
    if (grid < 0) return;
    if (hipMemsetAsync((char*)d_ws + WS_CTL, 0, CTL_ZERO_BYTES, stream) != hipSuccess) { fprintf(stderr, "kernel_launch: memset failed\n"); return; }
    Args a{};
    for (int i = 0; i < 30; ++i) a.in[i] = d_in[i];
    a.out = (float*)d_out; a.ws = (unsigned char*)d_ws;
#if MK_ONE_LAUNCH
    a.ph_lo = 0; a.ph_hi = N_PHASES; a.li = 0;
    hipLaunchKernelGGL(mk_fwd, dim3(grid), dim3(NWAVES * 64), LDS_BYTES, stream, a);
#else
    for (int p = 0; p < N_PHASES; ++p) { a.ph_lo = p; a.ph_hi = p + 1; a.li = 0; hipLaunchKernelGGL(mk_fwd, dim3(grid), dim3(NWAVES * 64), LDS_BYTES, stream, a);
#if MK_CHECK
        { unsigned* fl = (unsigned*)((char*)d_ws + WS_CTL) + 8; const size_t NI = (size_t)4096 * 4096;
          if (p == 5) { hipLaunchKernelGGL(chk_scan, dim3(1024), dim3(256), 0, stream, (const bf16_t*)d_out, NI, fl + 0); hipLaunchKernelGGL(chk_scan, dim3(1024), dim3(256), 0, stream, (const bf16_t*)((char*)d_out + 32 * MiB), NI, fl + 2);
                        hipLaunchKernelGGL(chk_scan, dim3(1024), dim3(256), 0, stream, (const bf16_t*)((char*)d_out + 64 * MiB), NI, fl + 4); hipLaunchKernelGGL(chk_scan, dim3(1024), dim3(256), 0, stream, (const bf16_t*)((char*)d_out + 96 * MiB), NI, fl + 6); }
          if (p == 6) hipLaunchKernelGGL(chk_scan, dim3(1024), dim3(256), 0, stream, (const bf16_t*)((char*)d_ws + WS_H + 16 * MiB), NI, fl + 8);
          if (p == 7 && MK_RPT >= 100) hipLaunchKernelGGL(chk_rwkv, dim3(1), dim3(64), 0, stream, a, 3, 15, 4096);
          if (p == 7) hipLaunchKernelGGL(chk_scan, dim3(1024), dim3(256), 0, stream, (const bf16_t*)((char*)d_ws + WS_YCAT), (size_t)TOK * DM, fl + 10); }
#endif
    }
#if MK_CHECK
    if (MK_RPT >= 100) hipLaunchKernelGGL(chk_apply2, dim3(1024), dim3(256), 0, stream, a); else hipLaunchKernelGGL(chk_apply, dim3(1024), dim3(256), 0, stream, a);
#endif
#endif
    const hipError_t le = hipPeekAtLastError();
    if (le != hipSuccess) fprintf(stderr, "kernel_launch: launch failed: %s\n", hipGetErrorName(le));
}
```
